# Optimizing an MI355X kernel written in HIP

```python
import math
import jax, jax.numpy as jnp
from jax import lax
import numpy as np

D_MODEL = 1024
BATCH = 32
SEQ = 2048
DEPTH = 1

CHUNK = 64
Q_BLOCK = 128
EPS = 1e-6
H_A = 4
DH_A = 64
W_A = H_A * 2 * DH_A
H_B = 8
DH_B = 64
W_B = H_B * DH_B
H_I = 4
D_I = 64
TOPK_MAX = 256
N_MEM = 256
H_X = 4
DH_X = D_MODEL // H_X
N_GROUPS = 4
EXP_PER_GROUP = 8
N_EXPERTS = N_GROUPS * EXP_PER_GROUP
TOP_K_INNER = 2
D_EXPERT = 512
MOE_BLOCK = 256

IN_WIDTHS = (H_A * 2 * DH_A, H_A * 2 * DH_A, H_A * 2 * DH_A, H_B * DH_B, DH_B, DH_B, H_I * D_I, D_I, H_I)
D_IN = sum(IN_WIDTHS)
IN_SPLITS = tuple(sum(IN_WIDTHS[:i + 1]) for i in range(len(IN_WIDTHS) - 1))

kernel_name = "hybrid_diff_dsa_hiermoe_block"


def rms_norm(x, g):
    xf = x.astype(jnp.float32)
    y = xf * lax.rsqrt(jnp.mean(xf * xf, axis=-1, keepdims=True) + EPS)
    return (y * g.astype(jnp.float32)).astype(x.dtype)


def alibi_slopes(n):
    return jnp.asarray([2.0 ** (-8.0 * (i + 1) / n) for i in range(n)], dtype=jnp.float32)


def to_blocks(a):
    b, s = a.shape[:2]
    a = a.reshape((b, s // Q_BLOCK, Q_BLOCK) + a.shape[2:])
    return jnp.moveaxis(a, 1, 0)


def from_blocks(o):
    o = jnp.moveaxis(o, 0, 1)
    return o.reshape((o.shape[0], o.shape[1] * o.shape[2]) + o.shape[3:])


def chunk_allowed(t, s):
    return (t[:, None] // CHUNK) >= (s[None, :] // CHUNK)


def diff_attention(q, k, v, lam, slopes):
    s_len = q.shape[1]
    pos = jnp.arange(s_len, dtype=jnp.int32)
    scale = DH_A ** -0.5

    def one_block(args):
        q_blk, t = args
        sc = jnp.einsum('bqhmd,bshmd->bhmqs', q_blk, k).astype(jnp.float32) * scale
        dist = jnp.abs(t[:, None] - pos[None, :]).astype(jnp.float32)
        sc = sc - slopes[None, :, None, None, None] * dist
        sc = jnp.where(chunk_allowed(t, pos), sc, -jnp.inf)
        p = jax.nn.softmax(sc, axis=-1)
        a = p[:, :, 0] - lam * p[:, :, 1]
        return jnp.einsum('bhqs,bshe->bqhe', a.astype(v.dtype), v)

    o = lax.map(one_block, (to_blocks(q), pos.reshape(-1, Q_BLOCK)))
    return from_blocks(o)


def dsa_attention(q, k, v, q_idx, k_idx, w_idx, slopes, k_sel):
    s_len = q.shape[1]
    pos = jnp.arange(s_len, dtype=jnp.int32)
    scale = DH_B ** -0.5
    gather = jax.vmap(lambda arr, ii: arr[ii])

    def one_block(args):
        q_blk, qi_blk, wi_blk, t = args
        dots = jnp.einsum('bqhd,bsd->bqhs', qi_blk, k_idx).astype(jnp.float32)
        isc = jnp.einsum('bqhs,bqh->bqs', jax.nn.relu(dots), wi_blk.astype(jnp.float32))
        isc = jnp.where(chunk_allowed(t, pos)[None], isc, -jnp.inf)
        top_val, top_idx = lax.top_k(isc, k_sel)
        valid = top_val > -jnp.inf
        k_g = gather(k, top_idx)
        v_g = gather(v, top_idx)
        sc = jnp.einsum('bqhd,bqkd->bhqk', q_blk, k_g).astype(jnp.float32) * scale
        dist = jnp.abs(t[None, :, None] - top_idx).astype(jnp.float32)
        sc = sc - slopes[None, :, None, None] * dist[:, None]
        sc = jnp.where(valid[:, None], sc, -jnp.inf)
        p = jax.nn.softmax(sc, axis=-1)
        return jnp.einsum('bhqk,bqkd->bqhd', p.astype(v.dtype), v_g)

    o = lax.map(one_block, (to_blocks(q), to_blocks(q_idx), to_blocks(w_idx), pos.reshape(-1, Q_BLOCK)))
    return from_blocks(o)


def memory_cross_attention(xn, memn, w_cq, w_ckv, w_co):
    b, s, d = xn.shape
    m = memn.shape[1]
    q = (xn @ w_cq).reshape(b, s, H_X, DH_X)
    k, v = jnp.split((memn @ w_ckv).reshape(m and b, m, 2, H_X, DH_X), 2, axis=2)
    k, v = k[:, :, 0], v[:, :, 0]
    sc = jnp.einsum('bshd,bmhd->bhsm', q, k).astype(jnp.float32) * (DH_X ** -0.5)
    p = jax.nn.softmax(sc, axis=-1)
    o = jnp.einsum('bhsm,bmhd->bshd', p.astype(v.dtype), v).reshape(b, s, d)
    return o @ w_co


def hier_moe(x2, w_group, b_group, w_router, b_router, w1, w3, w2):
    n, d = x2.shape
    g_logits = (x2 @ w_group).astype(jnp.float32) + b_group.astype(jnp.float32)
    p_group = jax.nn.softmax(g_logits, axis=-1)
    g_idx = jnp.argmax(g_logits, axis=-1).astype(jnp.int32)
    p_g = jnp.take_along_axis(p_group, g_idx[:, None], axis=1)[:, 0]
    e_logits = ((x2 @ w_router).astype(jnp.float32) + b_router.astype(jnp.float32)).reshape(n, N_GROUPS, EXP_PER_GROUP)
    e_in = jnp.take_along_axis(e_logits, g_idx[:, None, None], axis=1)[:, 0]
    top_p, top_i = lax.top_k(jax.nn.softmax(e_in, axis=-1), TOP_K_INNER)
    gate = p_g[:, None] * top_p / jnp.sum(top_p, axis=-1, keepdims=True)
    expert = g_idx[:, None] * EXP_PER_GROUP + top_i.astype(jnp.int32)

    flat_e = expert.reshape(-1)
    n_assign = flat_e.shape[0]
    flat_tok = jnp.repeat(jnp.arange(n, dtype=jnp.int32), TOP_K_INNER)
    flat_gate = gate.reshape(-1)
    order = jnp.argsort(flat_e)
    sorted_e = flat_e[order]
    counts = jnp.bincount(flat_e, length=N_EXPERTS).astype(jnp.int32)
    padded = (counts + MOE_BLOCK - 1) // MOE_BLOCK * MOE_BLOCK
    pad_end = jnp.cumsum(padded)
    pad_start = pad_end - padded
    start = jnp.cumsum(counts) - counts
    rank = jnp.arange(n_assign, dtype=jnp.int32) - start[sorted_e]
    dest = pad_start[sorted_e] + rank
    n_blocks = -(-n_assign // MOE_BLOCK) + N_EXPERTS
    n_slots = n_blocks * MOE_BLOCK
    slot_tok = jnp.full((n_slots,), n, dtype=jnp.int32).at[dest].set(flat_tok[order])
    slot_gate = jnp.zeros((n_slots,), jnp.float32).at[dest].set(flat_gate[order])
    block_expert = jnp.minimum(
        jnp.searchsorted(pad_end, jnp.arange(n_blocks, dtype=jnp.int32) * MOE_BLOCK, side='right'),
        N_EXPERTS - 1).astype(jnp.int32)
    x_pad = jnp.concatenate([x2, jnp.zeros((1, d), x2.dtype)], axis=0)

    def expert_block(args):
        tok, gte, e = args
        xb = x_pad[tok]
        hb = jax.nn.silu(xb @ w1[e]) * (xb @ w3[e])
        return (hb @ w2[e]) * gte[:, None].astype(x2.dtype)

    y_slots = lax.map(expert_block, (slot_tok.reshape(n_blocks, MOE_BLOCK),
                                     slot_gate.reshape(n_blocks, MOE_BLOCK), block_expert))
    y = jnp.zeros((n + 1, d), x2.dtype).at[slot_tok].add(y_slots.reshape(n_slots, d))
    return y[:n]


def setup_inputs(seed: int = 0) -> dict:
    key = jax.random.key(seed)
    ks = jax.random.split(key, 32)

    def nrm(k, shape, scale):
        return jax.random.normal(k, shape, jnp.float32) * scale

    def gain(k, shape):
        return 1.0 + 0.02 * jax.random.normal(k, shape, jnp.float32)

    L, D = DEPTH, D_MODEL
    return {
        "x": nrm(ks[0], (BATCH, SEQ, D), 1.0),
        "mem": nrm(ks[1], (BATCH, N_MEM, D), 1.0),
        "mix_norm": gain(ks[2], (L, D)),
        "w_in": nrm(ks[3], (L, D, D_IN), D ** -0.5),
        "lam_q1": nrm(ks[4], (L, DH_A), 0.1),
        "lam_k1": nrm(ks[5], (L, DH_A), 0.1),
        "lam_q2": nrm(ks[6], (L, DH_A), 0.1),
        "lam_k2": nrm(ks[7], (L, DH_A), 0.1),
        "diff_subln": gain(ks[8], (L, 2 * DH_A)),
        "w_branch_a": nrm(ks[9], (L, W_A, D), W_A ** -0.5),
        "w_branch_b": nrm(ks[10], (L, W_B, D), W_B ** -0.5),
        "w_gate": nrm(ks[11], (L, D, 2 * D), D ** -0.5),
        "b_gate": nrm(ks[12], (L, 2 * D), 0.02),
        "w_out": nrm(ks[13], (L, D, D), D ** -0.5),
        "cross_norm": gain(ks[14], (L, D)),
        "mem_norm": gain(ks[15], (L, D)),
        "w_cq": nrm(ks[16], (L, D, D), D ** -0.5),
        "w_ckv": nrm(ks[17], (L, D, 2 * D), D ** -0.5),
        "w_co": nrm(ks[18], (L, D, D), D ** -0.5),
        "ffn_norm": gain(ks[19], (L, D)),
        "w_group": nrm(ks[20], (L, D, N_GROUPS), D ** -0.5),
        "b_group": nrm(ks[21], (L, N_GROUPS), 0.01),
        "w_router": nrm(ks[22], (L, D, N_EXPERTS), D ** -0.5),
        "b_router": nrm(ks[23], (L, N_EXPERTS), 0.01),
        "w1": nrm(ks[24], (L, N_EXPERTS, D, D_EXPERT), D ** -0.5),
        "w3": nrm(ks[25], (L, N_EXPERTS, D, D_EXPERT), D ** -0.5),
        "w2": nrm(ks[26], (L, N_EXPERTS, D_EXPERT, D), D_EXPERT ** -0.5),
        "final_norm": gain(ks[27], (D,)),
    }


def reference(x, mem, mix_norm, w_in, lam_q1, lam_k1, lam_q2, lam_k2, diff_subln, w_branch_a, w_branch_b,
              w_gate, b_gate, w_out, cross_norm, mem_norm, w_cq, w_ckv, w_co, ffn_norm, w_group, b_group,
              w_router, b_router, w1, w3, w2, final_norm):
    b, s, d = x.shape
    k_sel = min(TOPK_MAX, s // 4)
    slopes_a = alibi_slopes(H_A)
    slopes_b = alibi_slopes(H_B)
    h = x
    for l in range(DEPTH):
        lambda_init = 0.8 - 0.6 * math.exp(-0.3 * l)
        xn = rms_norm(h, mix_norm[l])
        q_a, k_a, v_a, q_b, k_b, v_b, q_i, k_i, w_i = jnp.split(xn @ w_in[l], IN_SPLITS, axis=-1)
        lam = (jnp.exp(jnp.sum(lam_q1[l].astype(jnp.float32) * lam_k1[l].astype(jnp.float32)))
               - jnp.exp(jnp.sum(lam_q2[l].astype(jnp.float32) * lam_k2[l].astype(jnp.float32)))
               + lambda_init)
        y_a = diff_attention(q_a.reshape(b, s, H_A, 2, DH_A), k_a.reshape(b, s, H_A, 2, DH_A),
                             v_a.reshape(b, s, H_A, 2 * DH_A), lam, slopes_a)
        y_a = (rms_norm(y_a, diff_subln[l]) * (1.0 - lambda_init)).reshape(b, s, W_A)
        y_b = dsa_attention(q_b.reshape(b, s, H_B, DH_B), k_b, v_b,
                            q_i.reshape(b, s, H_I, D_I), k_i,
                            w_i * (H_I ** -0.5 * D_I ** -0.5), slopes_b, k_sel).reshape(b, s, W_B)
        gates = jax.nn.sigmoid((xn @ w_gate[l]).astype(jnp.float32) + b_gate[l].astype(jnp.float32)).astype(h.dtype)
        g_a, g_b = jnp.split(gates, 2, axis=-1)
        merged = g_a * (y_a @ w_branch_a[l]) + g_b * (y_b @ w_branch_b[l])
        h = h + merged @ w_out[l]
        h = h + memory_cross_attention(rms_norm(h, cross_norm[l]), rms_norm(mem, mem_norm[l]),
                                       w_cq[l], w_ckv[l], w_co[l])
        y_f = hier_moe(rms_norm(h, ffn_norm[l]).reshape(b * s, d), w_group[l], b_group[l],
                       w_router[l], b_router[l], w1[l], w3[l], w2[l])
        h = h + y_f.reshape(b, s, d)
    return rms_norm(h, final_norm)
```

```cpp
#include <hip/hip_runtime.h>
#include <cstdio>
#include <cstdint>

#ifndef N_LAUNCH_SPLIT
#define N_LAUNCH_SPLIT 0
#endif

#ifndef REP_PHASE
#define REP_PHASE (-1)
#endif
#define REPS(k) ((REP_PHASE == (k)) ? 2 : 1)
#define LAS __attribute__((address_space(3)))
#define GAS __attribute__((address_space(1)))
typedef unsigned short bf16_t;
typedef short bf16x8 __attribute__((ext_vector_type(8)));
typedef short s16x4 __attribute__((ext_vector_type(4)));
typedef float f32x2 __attribute__((ext_vector_type(2)));
typedef float f32x4 __attribute__((ext_vector_type(4)));
typedef float f32x16 __attribute__((ext_vector_type(16)));
typedef unsigned u32x2 __attribute__((ext_vector_type(2)));
typedef unsigned u32x4 __attribute__((ext_vector_type(4)));
typedef __bf16 bf16x2_t __attribute__((ext_vector_type(2)));
typedef int v4i32 __attribute__((ext_vector_type(4)));
typedef int v8i32 __attribute__((ext_vector_type(8)));

constexpr int NB = 32, SEQ = 2048, DM = 1024, NTOK = NB * SEQ, NMEM = 256;
constexpr int PW = 2560;
constexpr int C_QA = 0, C_KA = 512, C_VA = 1024, C_QB = 1536, C_KB = 2048, C_VB = 2112, C_QI = 2176, C_KI = 2432, C_WI = 2496;
constexpr int NEXP = 32, DEXP = 512;
constexpr int MAXSLOT = 2 * NTOK + NEXP * 256;
constexpr float EPS = 1e-6f, LOG2E = 1.4426950408889634f;

constexpr size_t MiB = 1u << 20;
constexpr size_t WS_CTL = 0, CTL_ZERO_BYTES = 64 * 1024;
constexpr size_t WS_ROWSS = 512 * 1024;
constexpr size_t WS_TOKE = 1 * MiB;
constexpr size_t WS_TOKG = WS_TOKE + 256 * 1024;
constexpr size_t WS_TOKINV = WS_TOKG + 512 * 1024;
constexpr size_t WS_HIST = 2 * MiB;
constexpr size_t WS_WRT  = WS_HIST + 32 * 1024;
constexpr size_t WS_SDEST = 2 * MiB + 256 * 1024;
constexpr size_t WS_STOK  = WS_SDEST + 576 * 1024;
constexpr size_t WS_SGATE = WS_STOK + 576 * 1024;
static_assert(WS_WRT + 36 * 1024 * 4 <= WS_SDEST && WS_SGATE + (size_t)MAXSLOT * 4 <= 4 * MiB && (size_t)MAXSLOT * 4 <= 576 * 1024, "small arrays");
constexpr size_t WS_WCAT = 4 * MiB;
constexpr size_t WS_WA = 13 * MiB, WS_WB = 14 * MiB, WS_WOUT = 15 * MiB, WS_WCQ = 17 * MiB, WS_WCKV = 19 * MiB, WS_WCO = 23 * MiB;
constexpr size_t WS_W13 = 25 * MiB;
constexpr size_t WS_W2 = 89 * MiB;
constexpr size_t WS_MEMN = 121 * MiB;
constexpr size_t WS_KVC = 137 * MiB;
constexpr size_t WS_R1 = 176 * MiB;
constexpr size_t WS_R2 = 304 * MiB;
constexpr size_t WS_R3 = 624 * MiB;
constexpr size_t WS_R4 = 880 * MiB;
constexpr size_t WS_SIV = 1016 * MiB;
constexpr size_t WS_END = 1017 * MiB;
static_assert(WS_R4 + (size_t)MAXSLOT * DEXP * 2 <= WS_SIV && WS_SIV + (size_t)MAXSLOT * 4 <= WS_END, "ws map");
static_assert(WS_R2 + (size_t)MAXSLOT * DM * 2 <= WS_R3, "ws map");
constexpr int CW_BAR = 1024;

constexpr int SCR_BYTES = 135424;
constexpr int ISC_PITCH = 4232;
constexpr int MASK_OFF = SCR_BYTES, MASK_PITCH_W = 66;
constexpr int TAB_OFF = MASK_OFF + 32 * MASK_PITCH_W * 4;
constexpr int TAB_BYTES = 8192;
constexpr int QIDX_OFF = TAB_OFF;
constexpr int MISC_OFF = 163840 - 256;
constexpr int LDS_BYTES = MISC_OFF + 256;
static_assert(TAB_OFF % 16 == 0 && MISC_OFF % 16 == 0 && LDS_BYTES <= 163840 && TAB_OFF + TAB_BYTES <= MISC_OFF && QIDX_OFF + 32 * 528 <= MISC_OFF, "lds map");

__device__ __forceinline__ unsigned cvt_pk_bf16(float lo, float hi) { f32x2 v = {lo, hi}; bf16x2_t b = __builtin_convertvector(v, bf16x2_t); return __builtin_bit_cast(unsigned, b); }
__device__ __forceinline__ unsigned pack4_fp8(float a, float b, float c, float d) { int w = 0; w = __builtin_amdgcn_cvt_pk_fp8_f32(a, b, w, false); w = __builtin_amdgcn_cvt_pk_fp8_f32(c, d, w, true); return (unsigned)w; }
__device__ __forceinline__ float bf_lo(unsigned w) { return __uint_as_float(w << 16); }
__device__ __forceinline__ float bf_hi(unsigned w) { return __uint_as_float(w & 0xffff0000u); }
__device__ __forceinline__ float bf2f(bf16_t b) { return __uint_as_float((unsigned)b << 16); }
__device__ __forceinline__ float wave_sum(float v) {
#pragma unroll
    for (int o = 1; o < 64; o <<= 1) v += __shfl_xor(v, o);
    return v;
}
__device__ __forceinline__ float xor32_sum(float v) {
    const auto rr = __builtin_amdgcn_permlane32_swap(__float_as_uint(v), __float_as_uint(v), false, false);
    return __uint_as_float(rr[0]) + __uint_as_float(rr[1]);
}
__device__ __forceinline__ float fexp2(float x) { return __builtin_amdgcn_exp2f(x); }
__device__ __forceinline__ float frcp(float x) { return __builtin_amdgcn_rcpf(x); }
__device__ __forceinline__ int crow(int r, int hi) { return (r & 3) + 8 * (r >> 2) + 4 * hi; }
#define LDS_WAIT() asm volatile("s_waitcnt lgkmcnt(0)" ::: "memory")
#define VM_WAIT() asm volatile("s_waitcnt vmcnt(0)" ::: "memory")

namespace pg8 {
constexpr int BM = 256, BK = 64, HALF = 128, HTB = HALF * BK * 2, NXCD = 8, WGM = 8;
__host__ __device__ __forceinline__ int lds_byte(int r, int c) { const int st = (r >> 4) * 2 + (c >> 5), rr = r & 15, cc = c & 31, ob = rr * 64 + cc * 2; return st * 1024 + (ob ^ (((ob >> 9) & 1) << 5)); }
__host__ __device__ __forceinline__ void stage_rc(int b, int& R, int& C) { const int st = b / 1024, sb = b % 1024, swz = sb ^ (((sb >> 9) & 1) << 5); R = (st >> 1) * 16 + swz / 64; C = (st & 1) * 32 + (swz % 64) / 2; }
__host__ __device__ __forceinline__ int perm32(int rho) { const int n = rho >> 4, i = rho & 15; return 8 * (i >> 2) + 4 * n + (i & 3); }

struct Unit { int pm, pn, e; };
struct Gemm { const bf16_t* A; const bf16_t* Bt; int K; };

struct StaticOrder {
    int nM, nN, nwg, G, c; size_t tstep;
    __device__ void init(int M, int N, int K, int G_, int c_) { nM = M / BM; nN = N / BM; nwg = nM * nN; G = G_; c = c_; tstep = (size_t)BM * K * 2; }
    __device__ __forceinline__ bool next(int i, Unit& u) const {
        const long L = (long)i * G + c; if (L >= nwg) return false;
        int wgid = (int)L; { const int q = nwg / NXCD, r = nwg % NXCD, xcd = wgid % NXCD, off = wgid / NXCD; wgid = (xcd < r ? xcd * (q + 1) : r * (q + 1) + (xcd - r) * q) + off; }
        const int nig = WGM * nN, gid = wgid / nig, fm = gid * WGM, gsz = (nM - fm) < WGM ? (nM - fm) : WGM;
        u.pm = fm + ((wgid % nig) % gsz); u.pn = (wgid % nig) / gsz; u.e = 0; return true;
    }
    __device__ __forceinline__ const char* pa(const Gemm& g, const Unit& u) const { return (const char*)g.A + (size_t)u.pm * tstep; }
    __device__ __forceinline__ const char* pb(const Gemm& g, const Unit& u) const { return (const char*)g.Bt + (size_t)u.pn * tstep; }
    __device__ __forceinline__ const int* rowidx() const { return nullptr; }
};
struct MoeOrder {
    int G, c, n_units; const LAS unsigned char* rb2e; size_t a_step, b_estep, b_tstep; const int* ridx;
    __device__ __forceinline__ const int* rowidx() const { return ridx; }
    __device__ __forceinline__ bool next(int i, Unit& u) const {
        const int L = i * G + c; if (L >= n_units) return false;
        u.pm = L >> 2; u.pn = L & 3; u.e = rb2e[u.pm]; return true;
    }
    __device__ __forceinline__ const char* pa(const Gemm& g, const Unit& u) const { return (const char*)g.A + (size_t)u.pm * a_step; }
    __device__ __forceinline__ const char* pb(const Gemm& g, const Unit& u) const { return (const char*)g.Bt + (size_t)u.e * b_estep + (size_t)u.pn * b_tstep; }
};

template <bool F8> struct FragT;
template <class E> struct EpiBadj { static constexpr bool v = false; };
template <class E> struct EpiMid { static constexpr bool v = false; };
template <> struct FragT<false> {
    struct Fr { bf16x8 k[2]; }; struct A4 { Fr f[4]; }; struct B2 { Fr f[2]; };
    static __device__ __forceinline__ void load(Fr& d, const LAS unsigned char* p) { d.k[0] = *(const LAS bf16x8*)p; d.k[1] = *(const LAS bf16x8*)(p + 1024); }
    static __device__ __forceinline__ void mma(f32x4& c, const Fr& b, const Fr& a) { c = __builtin_amdgcn_mfma_f32_16x16x32_bf16(b.k[0], a.k[0], c, 0, 0, 0); c = __builtin_amdgcn_mfma_f32_16x16x32_bf16(b.k[1], a.k[1], c, 0, 0, 0); }
};
template <> struct FragT<true> {
    struct Fr { v8i32 v; }; struct A4 { Fr f[4]; }; struct B2 { Fr f[2]; };
    static __device__ __forceinline__ void load(Fr& d, const LAS unsigned char* p) { const v4i32 lo = *(const LAS v4i32*)p, hi = *(const LAS v4i32*)(p + 1024); d.v = __builtin_shufflevector(lo, hi, 0, 1, 2, 3, 4, 5, 6, 7); }
    static __device__ __forceinline__ void mma(f32x4& c, const Fr& b, const Fr& a) {
        asm volatile("v_mfma_scale_f32_16x16x128_f8f6f4 %0, %1, %2, %0, %3, %3 op_sel_hi:[0,0,0]" : "+v"(c) : "v"(b.v), "v"(a.v), "v"(0x7f7f7f7f)); }
};
template <bool GATHER = false, bool F8 = false, class Epi, class Sched>
__device__ __forceinline__ void gemm_phase(LAS unsigned char* lds, const Gemm g, const Sched& S, const Epi& E) {
    const int tid = threadIdx.x, wid = __builtin_amdgcn_readfirstlane(tid >> 6), lane = tid & 63, wr = wid >> 2, wc = wid & 3, fr = lane & 15, fq = lane >> 4;
    const int K = F8 ? g.K / 2 : g.K, nt = K / BK;
    unsigned voffB[2]; int RA[2], CA2[2];
    unsigned vA0c[2], vA1c[2], vA0n[2], vA1n[2];
    const size_t kstep = (size_t)(BK * 2);
    const size_t hstep = (size_t)HALF * K * 2;
    constexpr bool BADJ = EpiBadj<Epi>::v;
    const size_t hstepB = BADJ ? (size_t)8 * K * 2 : hstep;
#pragma unroll
    for (int i = 0; i < 2; ++i) { int R, C; stage_rc(tid * 16 + i * 8192, R, C); const int Rb = BADJ ? 64 * (R >> 5) + 16 * ((R & 15) >> 2) + 4 * ((R & 31) >> 4) + (R & 3) : (R & ~31) + perm32(R & 31);
        RA[i] = R; CA2[i] = C * 2; voffB[i] = (unsigned)(Rb * K + C) * 2u;
        vA0c[i] = (unsigned)(R * K + C) * 2u; vA1c[i] = vA0c[i] + (unsigned)hstep; vA0n[i] = vA0c[i]; vA1n[i] = vA1c[i]; }
#define PG8_ROWS(v0, v1, u) do { if (GATHER) { const int* ri_ = S.rowidx() + (size_t)(u).pm * BM; _Pragma("unroll") for (int i_ = 0; i_ < 2; ++i_) { \
        v0[i_] = (unsigned)ri_[RA[i_]] * (unsigned)(K * 2) + (unsigned)CA2[i_]; v1[i_] = (unsigned)ri_[HALF + RA[i_]] * (unsigned)(K * 2) + (unsigned)CA2[i_]; } \
        _Pragma("unroll") for (int i_ = 0; i_ < 2; ++i_) { asm volatile("" : "+v"(v0[i_])); asm volatile("" : "+v"(v1[i_])); } } } while (0)
#define PG8_SEL(n, c) (GATHER ? (last ? (n) : (c)) : (c))
    const unsigned ldsw = (unsigned)wid * 1024u;
    const int aoff = lds_byte(wr * 64 + fr, fq * 8), boff = lds_byte(wc * 32 + fr, fq * 8);
#define PG8_SA(b, h) (((b) * 2 + (h)) * HTB)
#define PG8_SB(b, h) ((4 + (b) * 2 + (h)) * HTB)
#define PG8_STAGE(bufoff, gbase, voff) do { _Pragma("unroll") for (int _i = 0; _i < 2; ++_i) \
        __builtin_amdgcn_global_load_lds((const unsigned*)((const char*)(gbase) + (voff)[_i]), (LAS unsigned*)(lds + (bufoff) + ldsw + _i * 8192), 16, 0, 0); } while (0)
#define PG8_LDA(dst, b, h) do { _Pragma("unroll") for (int m = 0; m < 4; ++m) FragT<F8>::load(dst.f[m], lds + PG8_SA(b, h) + aoff + m * 2048); } while (0)
#define PG8_LDB(dst, b, h) do { _Pragma("unroll") for (int n = 0; n < 2; ++n) FragT<F8>::load(dst.f[n], lds + PG8_SB(b, h) + boff + n * 2048); } while (0)
#define PG8_MMA(ai, bj, At, Bt) do { if constexpr (F8) __builtin_amdgcn_sched_barrier(0); __builtin_amdgcn_s_setprio(1); _Pragma("unroll") for (int m = 0; m < 4; ++m) _Pragma("unroll") for (int n = 0; n < 2; ++n) \
        FragT<F8>::mma(acc[ai][bj][m][n], Bt.f[n], At.f[m]); __builtin_amdgcn_s_setprio(0); if constexpr (F8) __builtin_amdgcn_sched_barrier(0); } while (0)
#define PG8_WAIT_V(n) asm volatile("s_waitcnt vmcnt(" #n ")" ::: "memory")
#define PG8_WAIT_L(n) asm volatile("s_waitcnt lgkmcnt(" #n ")" ::: "memory")
#define PG8_BAR __builtin_amdgcn_s_barrier()
#define PG8_SCHED __builtin_amdgcn_sched_barrier(0)
    Unit cur, nxt; int ui = 0;
    if (!S.next(0, cur)) return;
    f32x4 acc[2][2][4][2];
#pragma unroll
    for (int a = 0; a < 2; ++a)
#pragma unroll
        for (int b = 0; b < 2; ++b)
#pragma unroll
            for (int m = 0; m < 4; ++m)
#pragma unroll
                for (int n = 0; n < 2; ++n) acc[a][b][m][n] = (f32x4){0.f, 0.f, 0.f, 0.f};
    typedef typename FragT<F8>::A4 AFr; typedef typename FragT<F8>::B2 BFr;
    AFr At; BFr B0, B1;
    const char* cA = S.pa(g, cur); const char* cB = S.pb(g, cur);
    PG8_ROWS(vA0c, vA1c, cur);
    PG8_STAGE(PG8_SB(0, 0), cB, voffB); PG8_STAGE(PG8_SB(0, 1), cB + hstepB, voffB); PG8_STAGE(PG8_SA(0, 0), cA, vA0c); PG8_STAGE(PG8_SA(0, 1), cA, vA1c);
    if (wr == 1) PG8_BAR;
    PG8_WAIT_V(2); PG8_BAR;
    PG8_STAGE(PG8_SB(1, 0), cB + kstep, voffB); PG8_STAGE(PG8_SA(1, 0), cA + kstep, vA0c); PG8_STAGE(PG8_SB(1, 1), cB + hstepB + kstep, voffB);
    PG8_WAIT_V(6); PG8_BAR;
    for (;;) {
        const bool has_next = S.next(ui + 1, nxt);
        const char* nA = has_next ? S.pa(g, nxt) : cA; const char* nB = has_next ? S.pb(g, nxt) : cB;
        if (GATHER) { if (has_next) PG8_ROWS(vA0n, vA1n, nxt); else {
#pragma unroll
            for (int i = 0; i < 2; ++i) { vA0n[i] = vA0c[i]; vA1n[i] = vA1c[i]; } } }
#pragma unroll 1
        for (int t = 0; t < nt; t += 2) {
            const bool last = (t == nt - 2);
            const char* a1 = cA + (size_t)(t + 1) * kstep;
            const char* a2 = last ? nA : cA + (size_t)(t + 2) * kstep; const char* b2 = last ? nB : cB + (size_t)(t + 2) * kstep;
            const char* a3 = a2 + kstep; const char* b3 = b2 + kstep;
            unsigned w0[2], w1[2];
#pragma unroll
            for (int i = 0; i < 2; ++i) { w0[i] = PG8_SEL(vA0n[i], vA0c[i]); w1[i] = PG8_SEL(vA1n[i], vA1c[i]); }
            PG8_LDB(B0, 0, 0); PG8_LDB(B1, 0, 1); PG8_SCHED; PG8_LDA(At, 0, 0); PG8_STAGE(PG8_SA(1, 1), a1, vA1c);
            PG8_WAIT_V(8); PG8_WAIT_L(0); PG8_BAR; PG8_MMA(0, 0, At, B0); PG8_MMA(0, 1, At, B1); PG8_BAR; PG8_SCHED;
            PG8_LDA(At, 0, 1); PG8_STAGE(PG8_SB(0, 0), b2, voffB); PG8_STAGE(PG8_SB(0, 1), b2 + hstepB, voffB); PG8_STAGE(PG8_SA(0, 0), a2, w0);
            PG8_WAIT_V(8); PG8_WAIT_L(0); PG8_BAR; PG8_MMA(1, 0, At, B0); PG8_MMA(1, 1, At, B1); PG8_BAR; PG8_SCHED;
            PG8_LDB(B0, 1, 0); PG8_LDB(B1, 1, 1); PG8_SCHED; PG8_LDA(At, 1, 0); PG8_STAGE(PG8_SA(0, 1), a2, w1);
            PG8_WAIT_V(8); PG8_WAIT_L(0); PG8_BAR; PG8_MMA(0, 0, At, B0); PG8_MMA(0, 1, At, B1); PG8_BAR; PG8_SCHED;
            PG8_LDA(At, 1, 1); PG8_STAGE(PG8_SB(1, 0), b3, voffB); PG8_STAGE(PG8_SB(1, 1), b3 + hstepB, voffB); PG8_STAGE(PG8_SA(1, 0), a3, w0);
            PG8_WAIT_V(8); PG8_WAIT_L(0); PG8_BAR; PG8_MMA(1, 0, At, B0); PG8_MMA(1, 1, At, B1); PG8_BAR; PG8_SCHED;
            if constexpr (EpiMid<Epi>::v) { if (t == nt / 2 - 2) {
                if constexpr (F8) asm volatile("s_nop 15\n\ts_nop 15" ::: "memory");
                E.mid(acc, cur, wr, wc, fr, fq);
                if constexpr (F8) asm volatile("s_nop 7" ::: "memory"); PG8_SCHED; } }
        }
        if (wr == 0) PG8_BAR;
        if constexpr (F8) asm volatile("s_nop 15\n\ts_nop 15" ::: "memory");
        E(acc, cur, wr, wc, fr, fq);
        if (!has_next) break;
#pragma unroll
        for (int a = 0; a < 2; ++a)
#pragma unroll
            for (int b = 0; b < 2; ++b)
#pragma unroll
                for (int m = 0; m < 4; ++m)
#pragma unroll
                    for (int n = 0; n < 2; ++n) acc[a][b][m][n] = (f32x4){0.f, 0.f, 0.f, 0.f};
        cur = nxt; cA = nA; cB = nB; ++ui;
#pragma unroll
        for (int i = 0; i < 2; ++i) { vA0c[i] = vA0n[i]; vA1c[i] = vA1n[i]; }
        if (wr == 1) PG8_BAR;
    }
    PG8_WAIT_V(0);
    PG8_BAR;
#undef PG8_ROWS
#undef PG8_SEL
#undef PG8_SA
#undef PG8_SB
#undef PG8_STAGE
#undef PG8_LDA
#undef PG8_LDB
#undef PG8_MMA
#undef PG8_WAIT_V
#undef PG8_WAIT_L
#undef PG8_BAR
#undef PG8_SCHED
}

typedef f32x4 AccT[2][2][4][2];
__device__ __forceinline__ u32x4 pack8(const f32x4& v0, const f32x4& v1) { u32x4 w; w.x = cvt_pk_bf16(v0[0], v0[1]); w.y = cvt_pk_bf16(v0[2], v0[3]); w.z = cvt_pk_bf16(v1[0], v1[1]); w.w = cvt_pk_bf16(v1[2], v1[3]); return w; }
__device__ __forceinline__ void unpack8(const u32x4& w, f32x4& v0, f32x4& v1) { v0 = (f32x4){bf_lo(w.x), bf_hi(w.x), bf_lo(w.y), bf_hi(w.y)}; v1 = (f32x4){bf_lo(w.z), bf_hi(w.z), bf_lo(w.w), bf_hi(w.w)}; }
__device__ __forceinline__ float sigmoidf_(float v) { return frcp(1.f + fexp2(-v * LOG2E)); }
__device__ __forceinline__ unsigned pack4_u8(const f32x4& v) { unsigned w = 0u; w = __builtin_amdgcn_cvt_pk_u8_f32(v[0], 0u, w); w = __builtin_amdgcn_cvt_pk_u8_f32(v[1], 1u, w); w = __builtin_amdgcn_cvt_pk_u8_f32(v[2], 2u, w); w = __builtin_amdgcn_cvt_pk_u8_f32(v[3], 3u, w); return w; }
__device__ __forceinline__ f32x4 unpack4_u8(unsigned w) { return (f32x4){(float)(w & 0xffu), (float)((w >> 8) & 0xffu), (float)((w >> 16) & 0xffu), (float)(w >> 24)}; }

struct EpiProj {
    bf16_t* proj; unsigned char* gates; const LAS float* bgate; int mode;
    __device__ __forceinline__ void operator()(const AccT& acc, const Unit& u, int wr, int wc, int fr, int fq) const {
        const int row0 = u.pm * BM + wr * 64 + fr;
        if (mode == 1 || u.pn < 9) {
            const int col0 = (mode == 1 ? C_QI : 0) + u.pn * BM + wc * 32 + 8 * fq; const float sc = (mode == 1) ? 1.f : (1.f / 32.f);
            const int nbj = ((mode == 1 && u.pn == 1) || (mode == 0 && u.pn == 8)) ? 1 : 2;
#pragma unroll
            for (int ai = 0; ai < 2; ++ai)
#pragma unroll
                for (int m = 0; m < 4; ++m) { bf16_t* rowp = proj + (size_t)(row0 + ai * HALF + m * 16) * PW + col0;
#pragma unroll
                    for (int bj = 0; bj < 2; ++bj) if (bj < nbj) *(u32x4*)(rowp + bj * HALF) = pack8(acc[ai][bj][m][0] * sc, acc[ai][bj][m][1] * sc); }
        } else {
            const int col0 = (u.pn - 9) * BM + wc * 32 + 8 * fq;
            f32x4 bv[2][2];
#pragma unroll
            for (int bj = 0; bj < 2; ++bj)
#pragma unroll
                for (int n = 0; n < 2; ++n) bv[bj][n] = *(const LAS f32x4*)(bgate + col0 + bj * HALF + 4 * n);
#pragma unroll
            for (int ai = 0; ai < 2; ++ai)
#pragma unroll
                for (int m = 0; m < 4; ++m) { unsigned char* rowp = gates + (size_t)(row0 + ai * HALF + m * 16) * 2048 + col0;
#pragma unroll
                    for (int bj = 0; bj < 2; ++bj) { f32x4 v0 = acc[ai][bj][m][0] * (1.f / 32.f) + bv[bj][0], v1 = acc[ai][bj][m][1] * (1.f / 32.f) + bv[bj][1];
#pragma unroll
                        for (int j = 0; j < 4; ++j) { v0[j] = sigmoidf_(v0[j]) * 255.f; v1[j] = sigmoidf_(v1[j]) * 255.f; }
                        u32x2 w; w.x = pack4_u8(v0); w.y = pack4_u8(v1); *(u32x2*)(rowp + bj * HALF) = w; } }
        }
    }
};
template <bool SECOND> struct EpiBranch {
    const unsigned char* gates; bf16_t* merged; unsigned char* merged8; float sc;
    __device__ __forceinline__ void operator()(const AccT& acc, const Unit& u, int wr, int wc, int fr, int fq) const {
        const int row0 = u.pm * BM + wr * 64 + fr, col0 = u.pn * BM + wc * 32 + 8 * fq;
#pragma unroll
        for (int ai = 0; ai < 2; ++ai)
#pragma unroll
            for (int m = 0; m < 4; ++m) { const size_t row = (size_t)(row0 + ai * HALF + m * 16);
#pragma unroll
                for (int bj = 0; bj < 2; ++bj) { const int col = col0 + bj * HALF;
                    const u32x2 gw = *(const u32x2*)(gates + row * 2048 + (SECOND ? 1024 : 0) + col);
                    const f32x4 g0 = unpack4_u8(gw.x), g1 = unpack4_u8(gw.y);
                    f32x4 v0 = g0 * acc[ai][bj][m][0] * sc, v1 = g1 * acc[ai][bj][m][1] * sc;
                    if (SECOND) { const u32x4 pw = *(const u32x4*)(merged + row * 1024 + col); f32x4 p0, p1; unpack8(pw, p0, p1); v0 = (v0 + p0) * 8.f; v1 = (v1 + p1) * 8.f;
                        u32x2 w; w.x = pack4_fp8(v0[0], v0[1], v0[2], v0[3]); w.y = pack4_fp8(v1[0], v1[1], v1[2], v1[3]); *(u32x2*)(merged8 + row * 1024 + col) = w; }
                    else *(u32x4*)(merged + row * 1024 + col) = pack8(v0, v1); } }
    }
};
struct EpiBranchF {
    const unsigned char* gates; unsigned char* merged8;
    __device__ __forceinline__ void mid(AccT& acc, const Unit& u, int wr, int wc, int fr, int fq) const {
        unsigned gbase = (unsigned)(u.pm * BM + wr * 64 + fr) * 2048u + (unsigned)(u.pn * BM + wc * 64 + 16 * fq); asm volatile("" : "+v"(gbase));
#pragma unroll
        for (int ai = 0; ai < 2; ++ai) { asm volatile("" ::: "memory");
#pragma unroll
            for (int m = 0; m < 4; ++m) { const unsigned go = gbase + (unsigned)(ai * HALF + m * 16) * 2048u;
                const u32x4 ga = *(const u32x4*)(gates + go), gb = *(const u32x4*)(gates + (go + 1024));
#pragma unroll
                for (int bj = 0; bj < 2; ++bj) {
                    const f32x4 a0 = unpack4_u8(ga[2 * bj]), a1 = unpack4_u8(ga[2 * bj + 1]), b0 = unpack4_u8(gb[2 * bj]), b1 = unpack4_u8(gb[2 * bj + 1]);
#pragma unroll
                    for (int j = 0; j < 4; ++j) { acc[ai][bj][m][0][j] *= 2.f * a0[j] * frcp(fmaxf(b0[j], 1.f)); acc[ai][bj][m][1][j] *= 2.f * a1[j] * frcp(fmaxf(b1[j], 1.f)); } } } }
    }
    __device__ __forceinline__ void operator()(const AccT& acc, const Unit& u, int wr, int wc, int fr, int fq) const {
        unsigned rbase = (unsigned)(u.pm * BM + wr * 64 + fr) * 1024u + (unsigned)(u.pn * BM + wc * 64 + 16 * fq); asm volatile("" : "+v"(rbase));
        const unsigned cpart = rbase & 1023u, gbase = 2u * (rbase - cpart) + cpart;
#pragma unroll
        for (int ai = 0; ai < 2; ++ai)
#pragma unroll
            for (int m = 0; m < 4; ++m) { const unsigned go = gbase + (unsigned)(ai * HALF + m * 16) * 2048u, ro = rbase + (unsigned)(ai * HALF + m * 16) * 1024u;
                const u32x4 gb = *(const u32x4*)(gates + (go + 1024)); u32x4 w;
#pragma unroll
                for (int bj = 0; bj < 2; ++bj) {
                    const f32x4 b0 = unpack4_u8(gb[2 * bj]), b1 = unpack4_u8(gb[2 * bj + 1]);
                    f32x4 v0, v1;
#pragma unroll
                    for (int j = 0; j < 4; ++j) { v0[j] = acc[ai][bj][m][0][j] * fmaxf(b0[j], 1.f) * (1.f / (16.f * 255.f)); v1[j] = acc[ai][bj][m][1][j] * fmaxf(b1[j], 1.f) * (1.f / (16.f * 255.f)); }
                    w[2 * bj] = pack4_fp8(v0[0], v0[1], v0[2], v0[3]); w[2 * bj + 1] = pack4_fp8(v1[0], v1[1], v1[2], v1[3]); }
                *(u32x4*)(merged8 + ro) = w; }
    }
};
template <> struct EpiBadj<EpiBranchF> { static constexpr bool v = true; };
template <> struct EpiMid<EpiBranchF> { static constexpr bool v = true; };
struct EpiResid {
    const float* base; float* out; float sc;
    __device__ __forceinline__ void operator()(const AccT& acc, const Unit& u, int wr, int wc, int fr, int fq) const {
        const int row0 = u.pm * BM + wr * 64 + fr, col0 = u.pn * BM + wc * 32 + 8 * fq;
#pragma unroll
        for (int ai = 0; ai < 2; ++ai)
#pragma unroll
            for (int m = 0; m < 4; ++m) { const size_t off = (size_t)(row0 + ai * HALF + m * 16) * 1024 + col0;
#pragma unroll
                for (int bj = 0; bj < 2; ++bj) {
                    const f32x4 b0 = *(const f32x4*)(base + off + bj * HALF), b1 = *(const f32x4*)(base + off + bj * HALF + 4);
                    *(f32x4*)(out + off + bj * HALF) = b0 + acc[ai][bj][m][0] * sc; *(f32x4*)(out + off + bj * HALF + 4) = b1 + acc[ai][bj][m][1] * sc; } }
    }
};
struct EpiResidHb {
    const bf16_t* base; bf16_t* out; unsigned char* hb; const float* g; float sc;
    __device__ __forceinline__ void operator()(const AccT& acc, const Unit& u, int wr, int wc, int fr, int fq) const {
        const int row0 = u.pm * BM + wr * 64 + fr, col0 = u.pn * BM + wc * 32 + 8 * fq;
        f32x4 gv[2][2];
#pragma unroll
        for (int bj = 0; bj < 2; ++bj)
#pragma unroll
            for (int n = 0; n < 2; ++n) gv[bj][n] = *(const f32x4*)(g + col0 + bj * HALF + 4 * n);
#pragma unroll
        for (int ai = 0; ai < 2; ++ai)
#pragma unroll
            for (int m = 0; m < 4; ++m) { const size_t off = (size_t)(row0 + ai * HALF + m * 16) * 1024 + col0;
#pragma unroll
                for (int bj = 0; bj < 2; ++bj) {
                    f32x4 b0, b1; unpack8(*(const u32x4*)(base + off + bj * HALF), b0, b1);
                    const f32x4 v0 = b0 + acc[ai][bj][m][0] * sc, v1 = b1 + acc[ai][bj][m][1] * sc;
                    *(u32x4*)(out + off + bj * HALF) = pack8(v0, v1);
                    const f32x4 s0 = v0 * gv[bj][0], s1 = v1 * gv[bj][1];
                    u32x2 w; w.x = pack4_fp8(s0[0], s0[1], s0[2], s0[3]); w.y = pack4_fp8(s1[0], s1[1], s1[2], s1[3]);
                    *(u32x2*)(hb + off + bj * HALF) = w; } }
    }
};
struct EpiResidSq {
    const float* base; bf16_t* out; unsigned char* hb; const float* g; float* rowss; float sc;
    __device__ __forceinline__ void operator()(const AccT& acc, const Unit& u, int wr, int wc, int fr, int fq) const {
        const int row0 = u.pm * BM + wr * 64 + fr, col0 = u.pn * BM + wc * 32 + 8 * fq;
        f32x4 gv[2][2];
#pragma unroll
        for (int bj = 0; bj < 2; ++bj)
#pragma unroll
            for (int n = 0; n < 2; ++n) gv[bj][n] = *(const f32x4*)(g + col0 + bj * HALF + 4 * n);
#pragma unroll
        for (int ai = 0; ai < 2; ++ai)
#pragma unroll
            for (int m = 0; m < 4; ++m) { const int row = row0 + ai * HALF + m * 16; const size_t off = (size_t)row * 1024 + col0; float ss = 0.f;
#pragma unroll
                for (int bj = 0; bj < 2; ++bj) {
                    const f32x4 v0 = *(const f32x4*)(base + off + bj * HALF) + acc[ai][bj][m][0] * sc, v1 = *(const f32x4*)(base + off + bj * HALF + 4) + acc[ai][bj][m][1] * sc;
                    *(u32x4*)(out + off + bj * HALF) = pack8(v0, v1);
                    ss += (v0[0] * v0[0] + v0[1] * v0[1]) + (v0[2] * v0[2] + v0[3] * v0[3]) + (v1[0] * v1[0] + v1[1] * v1[1]) + (v1[2] * v1[2] + v1[3] * v1[3]);
                    const f32x4 s0 = v0 * gv[bj][0], s1 = v1 * gv[bj][1];
                    u32x2 w; w.x = pack4_fp8(s0[0], s0[1], s0[2], s0[3]); w.y = pack4_fp8(s1[0], s1[1], s1[2], s1[3]);
                    *(u32x2*)(hb + off + bj * HALF) = w; }
                ss += __shfl_xor(ss, 16); ss += __shfl_xor(ss, 32);
                if (fq == 0) atomicAdd(rowss + row, ss); }
    }
};
struct EpiRowScale {
    bf16_t* O; int ldc; const float* rowss; float sc;
    __device__ __forceinline__ void operator()(const AccT& acc, const Unit& u, int wr, int wc, int fr, int fq) const {
        const int row0 = u.pm * BM + wr * 64 + fr, col0 = u.pn * BM + wc * 32 + 8 * fq;
#pragma unroll
        for (int ai = 0; ai < 2; ++ai)
#pragma unroll
            for (int m = 0; m < 4; ++m) { const int row = row0 + ai * HALF + m * 16; const float rs = rsqrtf(rowss[row] * (1.f / 1024.f) + EPS) * sc;
                bf16_t* rowp = O + (size_t)row * ldc + col0;
#pragma unroll
                for (int bj = 0; bj < 2; ++bj) *(u32x4*)(rowp + bj * HALF) = pack8(acc[ai][bj][m][0] * rs, acc[ai][bj][m][1] * rs); }
    }
};
struct EpiPlain {
    bf16_t* O; int ldc; float sc;
    __device__ __forceinline__ void operator()(const AccT& acc, const Unit& u, int wr, int wc, int fr, int fq) const {
        const int row0 = u.pm * BM + wr * 64 + fr, col0 = u.pn * BM + wc * 32 + 8 * fq;
#pragma unroll
        for (int ai = 0; ai < 2; ++ai)
#pragma unroll
            for (int m = 0; m < 4; ++m) { bf16_t* rowp = O + (size_t)(row0 + ai * HALF + m * 16) * ldc + col0;
#pragma unroll
                for (int bj = 0; bj < 2; ++bj) *(u32x4*)(rowp + bj * HALF) = pack8(acc[ai][bj][m][0] * sc, acc[ai][bj][m][1] * sc); }
    }
};
struct EpiSwiGLU {
    unsigned char* hmid; const float* sgate; const float* siv;
    __device__ __forceinline__ void operator()(const AccT& acc, const Unit& u, int wr, int wc, int fr, int fq) const {
        const int row0 = u.pm * BM + wr * 64 + fr, col0 = u.pn * HALF + wc * 32 + 8 * fq;
#pragma unroll
        for (int ai = 0; ai < 2; ++ai)
#pragma unroll
            for (int m = 0; m < 4; ++m) { const size_t row = (size_t)(row0 + ai * HALF + m * 16); const float gt = sgate[row] * 8.f, iv = siv[row];
                f32x4 v[2];
#pragma unroll
                for (int n = 0; n < 2; ++n)
#pragma unroll
                    for (int j = 0; j < 4; ++j) { const float a = acc[ai][0][m][n][j] * iv, b = acc[ai][1][m][n][j] * iv; v[n][j] = gt * a * sigmoidf_(a) * b; }
                u32x2 w; w.x = pack4_fp8(v[0][0], v[0][1], v[0][2], v[0][3]); w.y = pack4_fp8(v[1][0], v[1][1], v[1][2], v[1][3]);
                *(u32x2*)(hmid + row * DEXP + col0) = w; }
    }
};
struct EpiDown {
    unsigned char* y2; const int* sdest;
    __device__ __forceinline__ void operator()(const AccT& acc, const Unit& u, int wr, int wc, int fr, int fq) const {
        const int row0 = u.pm * BM + wr * 64 + fr, col0 = u.pn * BM + wc * 64 + 16 * fq;
#pragma unroll
        for (int ai = 0; ai < 2; ++ai)
#pragma unroll
            for (int m = 0; m < 4; ++m) { const int dest = sdest[row0 + ai * HALF + m * 16];
                if (dest >= 0) { u32x4 w;
#pragma unroll
                    for (int bj = 0; bj < 2; ++bj) { const f32x4 a = acc[ai][bj][m][0] * (1.f / 16.f), b = acc[ai][bj][m][1] * (1.f / 16.f);
                        w[2 * bj] = pack4_fp8(a[0], a[1], a[2], a[3]); w[2 * bj + 1] = pack4_fp8(b[0], b[1], b[2], b[3]); }
                    *(u32x4*)(y2 + (size_t)dest * 1024 + col0) = w; } }
    }
};
template <> struct EpiBadj<EpiDown> { static constexpr bool v = true; };
}

#define XB_TMO      128
#define XB_XCNT(j)  (256  + 64 * (j))
#define XB_XSUB(j)  (1280 + 64 * (j))
#define XB_XGEN(j)  (2304 + 64 * (j))
#define XB_TOP      3328
#define XB_TOPGEN   3392
#define XCD_BAR_WORDS 3456
#define XB_SPIN_CAP (1u << 18)
__device__ __forceinline__ unsigned xb_ld(unsigned* p)              { return __hip_atomic_load(p, __ATOMIC_RELAXED, __HIP_MEMORY_SCOPE_AGENT); }
__device__ __forceinline__ unsigned xb_add(unsigned* p, unsigned v) { return __hip_atomic_fetch_add(p, v, __ATOMIC_RELAXED, __HIP_MEMORY_SCOPE_AGENT); }
__device__ __forceinline__ unsigned xb_xcc_id() { return (unsigned)__builtin_amdgcn_s_getreg((3 << 11) | 20) & 0xFu; }
#define XB_SPIN(cond, bar) do { unsigned _sp = 0; while (cond) { __builtin_amdgcn_s_sleep(1); \
    if ((++_sp & 255u) == 0u) { if (xb_ld(&(bar)[XB_TMO])) break; if (_sp > XB_SPIN_CAP) { atomicAdd(&(bar)[XB_TMO], 1u); break; } } } } while (0)
struct XcdBarrier { unsigned* bar; unsigned x; volatile LAS unsigned* st; };
__device__ __forceinline__ XcdBarrier xcd_barrier_post(unsigned* bar, volatile LAS unsigned* st) {
    XcdBarrier b; b.bar = bar; b.x = xb_xcc_id(); b.st = st;
    if (threadIdx.x == 0) (void)xb_add(&bar[XB_XCNT(b.x)], 1u);
    return b;
}
__device__ __forceinline__ void xcd_barrier_complete(unsigned* bar, unsigned x, unsigned& nloc, unsigned& nx) {
    const unsigned G = gridDim.x * gridDim.y * gridDim.z;
    unsigned sum, cnt, mine, sp = 0u;
    for (;;) {
        sum = 0u; cnt = 0u; mine = 0u;
#pragma unroll
        for (unsigned j = 0; j < 16; ++j) { const unsigned c = xb_ld(&bar[XB_XCNT(j)]); sum += c; cnt += (c > 0u) ? 1u : 0u; mine = (j == x) ? c : mine; }
        if (sum == G) break;
        __builtin_amdgcn_s_sleep(1);
        if ((++sp & 255u) == 0u) { if (xb_ld(&bar[XB_TMO])) break; if (sp > XB_SPIN_CAP) { atomicAdd(&bar[XB_TMO], 1u); break; } }
    }
    nloc = mine > 0u ? mine : 1u; nx = cnt > 0u ? cnt : 1u;
}
__device__ __forceinline__ void xcd_barrier(const XcdBarrier& b) {
    asm volatile("s_waitcnt vmcnt(0)" ::: "memory");
    __syncthreads();
    if (threadIdx.x == 0) {
        unsigned* bar = b.bar;
        __builtin_amdgcn_s_waitcnt(0);
        unsigned nloc = b.st[0], nx = b.st[1];
        if (nloc == 0u) { xcd_barrier_complete(bar, b.x, nloc, nx); b.st[0] = nloc; b.st[1] = nx; }
        const unsigned old = xb_add(&bar[XB_XSUB(b.x)], 1u);
        const unsigned gen = old / nloc;
        if (old + 1u == (gen + 1u) * nloc) {
            __builtin_amdgcn_fence(__ATOMIC_RELEASE, "agent");
            asm volatile("s_waitcnt vmcnt(0)" ::: "memory");
            const unsigned og = xb_add(&bar[XB_TOP], 1u);
            const unsigned tg = og / nx;
            if (og + 1u == (tg + 1u) * nx) xb_add(&bar[XB_TOPGEN], 1u);
            else XB_SPIN(xb_ld(&bar[XB_TOPGEN]) == tg, bar);
            __builtin_amdgcn_fence(__ATOMIC_ACQUIRE, "agent");
            xb_add(&bar[XB_XGEN(b.x)], 1u);
            asm volatile("s_waitcnt vmcnt(0)" ::: "memory");
        } else {
            XB_SPIN(xb_ld(&bar[XB_XGEN(b.x)]) == gen, bar);
            __builtin_amdgcn_fence(__ATOMIC_ACQUIRE, "agent");
            asm volatile("s_waitcnt vmcnt(0)" ::: "memory");
        }
    }
    __syncthreads();
}

__device__ __forceinline__ void tr_item(const float* src, int src_ld, int nvalid, int n0, int k0, bf16_t* dst, int K, LAS float* scr, int lane) {
    const int nn = n0 + (lane & 31); const bool ok = nn < nvalid;
    float t[32];
#pragma unroll
    for (int i = 0; i < 32; ++i) t[i] = ok ? src[(size_t)(k0 + 2 * i + (lane >> 5)) * src_ld + nn] : 0.f;
#pragma unroll
    for (int i = 0; i < 32; ++i) scr[(2 * i + (lane >> 5)) * 33 + (lane & 31)] = t[i];
    LDS_WAIT(); asm volatile("" ::: "memory");
    const int c = lane & 7;
#pragma unroll
    for (int j = 0; j < 4; ++j) { const int n = (lane >> 3) + 8 * j; const LAS float* s = scr + (8 * c) * 33 + n;
        u32x4 o; o.x = cvt_pk_bf16(s[0 * 33], s[1 * 33]); o.y = cvt_pk_bf16(s[2 * 33], s[3 * 33]); o.z = cvt_pk_bf16(s[4 * 33], s[5 * 33]); o.w = cvt_pk_bf16(s[6 * 33], s[7 * 33]);
        *(u32x4*)(dst + (size_t)n * K + k0 + 8 * c) = o; }
    LDS_WAIT(); asm volatile("" ::: "memory");
}
__device__ __forceinline__ void tr_item8(const float* src, int src_ld, int nvalid, int n0, int k0, unsigned char* dst, int K, float scale, LAS float* scr, int lane) {
    const int nn = n0 + (lane & 31); const bool ok = nn < nvalid;
    float t[32];
#pragma unroll
    for (int i = 0; i < 32; ++i) t[i] = ok ? src[(size_t)(k0 + 2 * i + (lane >> 5)) * src_ld + nn] : 0.f;
#pragma unroll
    for (int i = 0; i < 32; ++i) scr[(2 * i + (lane >> 5)) * 33 + (lane & 31)] = t[i] * scale;
    LDS_WAIT(); asm volatile("" ::: "memory");
    const int c = lane & 7;
#pragma unroll
    for (int j = 0; j < 4; ++j) { const int n = (lane >> 3) + 8 * j; const LAS float* s = scr + (8 * c) * 33 + n;
        u32x2 o; o.x = pack4_fp8(s[0 * 33], s[1 * 33], s[2 * 33], s[3 * 33]); o.y = pack4_fp8(s[4 * 33], s[5 * 33], s[6 * 33], s[7 * 33]);
        *(u32x2*)(dst + (size_t)n * K + k0 + 8 * c) = o; }
    LDS_WAIT(); asm volatile("" ::: "memory");
}
__device__ __forceinline__ void rms_row_bf16(const float* xrow, const float* g, bf16_t* orow, int lane) {
    const f32x4* xr = (const f32x4*)xrow + lane; const f32x4* gr = (const f32x4*)g + lane;
    f32x4 v[4]; float s = 0.f;
#pragma unroll
    for (int j = 0; j < 4; ++j) { v[j] = xr[64 * j]; s += (v[j].x * v[j].x + v[j].y * v[j].y) + (v[j].z * v[j].z + v[j].w * v[j].w); }
    const float r = rsqrtf(wave_sum(s) * (1.f / 1024.f) + EPS);
    u32x2* o8 = (u32x2*)orow + lane;
#pragma unroll
    for (int j = 0; j < 4; ++j) { const f32x4 gv = gr[64 * j]; u32x2 w; w.x = cvt_pk_bf16(v[j].x * r * gv.x, v[j].y * r * gv.y); w.y = cvt_pk_bf16(v[j].z * r * gv.z, v[j].w * r * gv.w); o8[64 * j] = w; }
}

template <bool ALSO_BF16>
__device__ __forceinline__ void rms_rows4_fp8(const float* x0, size_t rstride, const float* g, unsigned char* o80, bf16_t* o0, int lane) {
    f32x4 v[4][4];
#pragma unroll
    for (int q = 0; q < 4; ++q)
#pragma unroll
        for (int j = 0; j < 4; ++j) v[q][j] = ((const f32x4*)(x0 + q * rstride) + lane)[64 * j];
    const f32x4* gr = (const f32x4*)g + lane;
    f32x4 gv[4];
#pragma unroll
    for (int j = 0; j < 4; ++j) gv[j] = gr[64 * j];
#pragma unroll
    for (int q = 0; q < 4; ++q) { float s = 0.f;
#pragma unroll
        for (int j = 0; j < 4; ++j) s += (v[q][j].x * v[q][j].x + v[q][j].y * v[q][j].y) + (v[q][j].z * v[q][j].z + v[q][j].w * v[q][j].w);
        const float r = rsqrtf(wave_sum(s) * (1.f / 1024.f) + EPS);
        unsigned* o4 = (unsigned*)(o80 + q * rstride) + lane; u32x2* o8 = (u32x2*)(o0 + q * rstride) + lane;
#pragma unroll
        for (int j = 0; j < 4; ++j) { const float a = v[q][j].x * r * gv[j].x, b = v[q][j].y * r * gv[j].y, c = v[q][j].z * r * gv[j].z, d = v[q][j].w * r * gv[j].w;
            o4[64 * j] = pack4_fp8(a, b, c, d);
            if (ALSO_BF16) { u32x2 w; w.x = cvt_pk_bf16(a, b); w.y = cvt_pk_bf16(c, d); o8[64 * j] = w; } } }
}
template <bool ALSO_BF16>
__device__ __forceinline__ void rms_row_fp8(const float* xrow, const float* g, unsigned char* orow8, bf16_t* orow, int lane) {
    const f32x4* xr = (const f32x4*)xrow + lane; const f32x4* gr = (const f32x4*)g + lane;
    f32x4 v[4]; float s = 0.f;
#pragma unroll
    for (int j = 0; j < 4; ++j) { v[j] = xr[64 * j]; s += (v[j].x * v[j].x + v[j].y * v[j].y) + (v[j].z * v[j].z + v[j].w * v[j].w); }
    const float r = rsqrtf(wave_sum(s) * (1.f / 1024.f) + EPS);
    unsigned* o4 = (unsigned*)orow8 + lane; u32x2* o8 = (u32x2*)orow + lane;
#pragma unroll
    for (int j = 0; j < 4; ++j) { const f32x4 gv = gr[64 * j]; const float a = v[j].x * r * gv.x, b = v[j].y * r * gv.y, c = v[j].z * r * gv.z, d = v[j].w * r * gv.w;
        o4[64 * j] = pack4_fp8(a, b, c, d);
        if (ALSO_BF16) { u32x2 w; w.x = cvt_pk_bf16(a, b); w.y = cvt_pk_bf16(c, d); o8[64 * j] = w; } }
}
__device__ __forceinline__ s16x4 vtr(const LAS unsigned char* p) { return __builtin_bit_cast(s16x4, __builtin_amdgcn_ds_read_tr16_b64_v4i16((LAS s16x4*)p)); }

template <int N> struct QReg { const bf16x8 (&q)[N]; __device__ __forceinline__ bf16x8 get(int ks) const { return q[ks]; } };
struct QLds { const LAS unsigned char* p; __device__ __forceinline__ bf16x8 get(int ks) const { return *(const LAS bf16x8*)(p + ks * 32); } };
__device__ __forceinline__ float fmax3_(float a, float b, float c) { float r; asm("v_max3_f32 %0, %1, %2, %3" : "=v"(r) : "v"(a), "v"(b), "v"(c)); return r; }
__device__ __forceinline__ float fmax2_(float a, float b) { float r; asm("v_max_f32_e32 %0, %1, %2" : "=v"(r) : "v"(a), "v"(b)); return r; }
__device__ __forceinline__ float fadd_(float a, float b) { float r; asm("v_add_f32_e32 %0, %1, %2" : "=v"(r) : "v"(a), "v"(b)); return r; }
struct TileSc { float c1, c2, tt, fh; unsigned m0, m1; bool diag; };
template <int DQK, int DV, bool PVDB, bool BIAS, bool MASKED, class QS>
__device__ __forceinline__ void attn_tile(const LAS unsigned char* Kt, const int kpitch, const LAS unsigned char* Vt, const int vpitch,
                                          const QS& qf, f32x16 (&o)[DV / 32], float& m_run, float& l_run, const TileSc& sc, const f32x16& kb0, const f32x16& kb1, const int lane) {
    const int r32 = lane & 31, hi = lane >> 5;
    f32x16 p0, p1;
    const LAS unsigned char* kp = Kt + r32 * kpitch + hi * 16;
    {
        const bf16x8 k0 = *(const LAS bf16x8*)(kp), k1 = *(const LAS bf16x8*)(kp + 32 * kpitch); const bf16x8 qv = qf.get(0);
        if (BIAS && !sc.diag) { p0 = __builtin_amdgcn_mfma_f32_32x32x16_bf16(k0, qv, kb0, 0, 0, 0); p1 = __builtin_amdgcn_mfma_f32_32x32x16_bf16(k1, qv, kb1, 0, 0, 0); }
        else { f32x16 z;
#pragma unroll
            for (int r = 0; r < 16; ++r) z[r] = 0.f;
            p0 = __builtin_amdgcn_mfma_f32_32x32x16_bf16(k0, qv, z, 0, 0, 0); p1 = __builtin_amdgcn_mfma_f32_32x32x16_bf16(k1, qv, z, 0, 0, 0); }
    }
#pragma unroll
    for (int ks = 1; ks < DQK / 16; ++ks) {
        const bf16x8 k0 = *(const LAS bf16x8*)(kp + ks * 32);
        const bf16x8 k1 = *(const LAS bf16x8*)(kp + 32 * kpitch + ks * 32);
        const bf16x8 qv = qf.get(ks);
        p0 = __builtin_amdgcn_mfma_f32_32x32x16_bf16(k0, qv, p0, 0, 0, 0);
        p1 = __builtin_amdgcn_mfma_f32_32x32x16_bf16(k1, qv, p1, 0, 0, 0);
    }
    float cm = sc.c1;
    if (BIAS && sc.diag) {
#pragma unroll
        for (int r = 0; r < 16; ++r) { const float k0 = sc.c2 * ((float)((r & 3) + 8 * (r >> 2)) + sc.fh), k1 = k0 + 32.f * sc.c2;
            p0[r] = p0[r] * sc.c1 + fminf(k0, sc.tt - k0); p1[r] = p1[r] * sc.c1 + fminf(k1, sc.tt - k1); }
        cm = 1.f;
    }
    if (MASKED) {
#pragma unroll
        for (int r = 0; r < 16; ++r) { const int cp = (r & 3) + 8 * (r >> 2);
            const unsigned t0 = (unsigned)__builtin_amdgcn_sbfe((int)sc.m0, cp, 1), t1 = (unsigned)__builtin_amdgcn_sbfe((int)sc.m1, cp, 1);
            p0[r] = __uint_as_float((__float_as_uint(p0[r]) & t0) | (0xff800000u & ~t0)); p1[r] = __uint_as_float((__float_as_uint(p1[r]) & t1) | (0xff800000u & ~t1)); }
    }
    asm volatile("s_nop 15\n\ts_nop 7" : "+v"(p0), "+v"(p1));
    float mx;
    { float a = fmax3_(p0[0], p0[1], p1[0]), b = fmax3_(p0[2], p0[3], p1[1]); a = fmax3_(a, p1[2], p1[3]);
#pragma unroll
      for (int r = 4; r < 16; r += 4) { a = fmax3_(a, p0[r], p0[r + 1]); b = fmax3_(b, p0[r + 2], p0[r + 3]); a = fmax3_(a, p1[r], p1[r + 1]); b = fmax3_(b, p1[r + 2], p1[r + 3]); }
      mx = fmax2_(a, b);
      const auto rr = __builtin_amdgcn_permlane32_swap(__float_as_uint(mx), __float_as_uint(mx), false, false);
      mx = fmax2_(__uint_as_float(rr[0]), __uint_as_float(rr[1])) * cm; }
    if (__any(mx > m_run)) {
        const float mnew = fmaxf(m_run, mx);
        const float alpha = fexp2(m_run - mnew);
        m_run = mnew; l_run *= alpha;
#pragma unroll
        for (int e = 0; e < DV / 32; ++e)
#pragma unroll
            for (int r = 0; r < 16; ++r) o[e][r] *= alpha;
    }
    const float nm = -m_run;
#pragma unroll
    for (int r = 0; r < 16; ++r) { p0[r] = fexp2(__builtin_fmaf(p0[r], cm, nm)); p1[r] = fexp2(__builtin_fmaf(p1[r], cm, nm)); }
    { float s0 = p0[0] + p1[0], s1 = p0[1] + p1[1], s2 = p0[2] + p1[2], s3 = p0[3] + p1[3];
#pragma unroll
      for (int r = 4; r < 16; r += 4) { s0 += p0[r] + p1[r]; s1 += p0[r + 1] + p1[r + 1]; s2 += p0[r + 2] + p1[r + 2]; s3 += p0[r + 3] + p1[r + 3]; }
      l_run += (s0 + s1) + (s2 + s3); }
    u32x4 pw[4];
#pragma unroll
    for (int i = 0; i < 4; ++i) { pw[0][i] = cvt_pk_bf16(p0[2 * i], p0[2 * i + 1]); pw[1][i] = cvt_pk_bf16(p0[8 + 2 * i], p0[8 + 2 * i + 1]);
                                  pw[2][i] = cvt_pk_bf16(p1[2 * i], p1[2 * i + 1]); pw[3][i] = cvt_pk_bf16(p1[8 + 2 * i], p1[8 + 2 * i + 1]); }
    const int g = lane >> 4, i16 = lane & 15;
    const LAS unsigned char* vp = Vt + (4 * hi + (i16 >> 2)) * vpitch + ((g & 1) * 16 + 4 * (i16 & 3)) * 2;
    constexpr int NE = DV / 32;
    if constexpr (!PVDB) {
#pragma unroll
        for (int s = 0; s < 4; ++s) {
            const bf16x8 pa = __builtin_bit_cast(bf16x8, pw[s]);
#pragma unroll
            for (int e = 0; e < NE; ++e) {
                const s16x4 lo = vtr(vp + (16 * s) * vpitch + e * 64), hh = vtr(vp + (16 * s + 8) * vpitch + e * 64);
                const bf16x8 vf = (bf16x8){lo[0], lo[1], lo[2], lo[3], hh[0], hh[1], hh[2], hh[3]};
                o[e] = __builtin_amdgcn_mfma_f32_32x32x16_bf16(vf, pa, o[e], 0, 0, 0);
            }
        }
        return;
    }
    s16x4 vlo[2][NE], vhi[2][NE];
#pragma unroll
    for (int e = 0; e < NE; ++e) { vlo[0][e] = vtr(vp + e * 64); vhi[0][e] = vtr(vp + 8 * vpitch + e * 64); }
#pragma unroll
    for (int s = 0; s < 4; ++s) {
        if (s + 1 < 4) {
#pragma unroll
            for (int e = 0; e < NE; ++e) { vlo[(s + 1) & 1][e] = vtr(vp + (16 * (s + 1)) * vpitch + e * 64); vhi[(s + 1) & 1][e] = vtr(vp + (16 * (s + 1) + 8) * vpitch + e * 64); }
        }
        const bf16x8 pa = __builtin_bit_cast(bf16x8, pw[s]);
#pragma unroll
        for (int e = 0; e < NE; ++e) {
            const s16x4 lo = vlo[s & 1][e], hh = vhi[s & 1][e];
            const bf16x8 vf = (bf16x8){lo[0], lo[1], lo[2], lo[3], hh[0], hh[1], hh[2], hh[3]};
            o[e] = __builtin_amdgcn_mfma_f32_32x32x16_bf16(vf, pa, o[e], 0, 0, 0);
        }
    }
}
template <int ROWB> struct TileRegs { u32x4 v[(64 * ROWB / 16) / 512]; };
template <int ROWB>
__device__ __forceinline__ void tile_load(TileRegs<ROWB>& t, const bf16_t* gsrc, size_t gpitch_el, int tid) {
    constexpr int CPR = ROWB / 16, TOTAL = 64 * CPR;
#pragma unroll
    for (int c = 0; c < TOTAL / 512; ++c) { const int idx = tid + c * 512, row = idx / CPR, ch = idx % CPR;
        t.v[c] = *(const u32x4*)(gsrc + (size_t)row * gpitch_el + ch * 8); }
}
template <int ROWB>
__device__ __forceinline__ void tile_store(const TileRegs<ROWB>& t, LAS unsigned char* dst, int lpitch, int tid) {
    constexpr int CPR = ROWB / 16, TOTAL = 64 * CPR;
#pragma unroll
    for (int c = 0; c < TOTAL / 512; ++c) { const int idx = tid + c * 512, row = idx / CPR, ch = idx % CPR;
        *(LAS u32x4*)(dst + row * lpitch + ch * 16) = t.v[c]; }
}
template <int ROWB>
__device__ __forceinline__ void stage_tile(const bf16_t* gsrc, size_t gpitch_el, LAS unsigned char* dst, int lpitch, int tid) {
    constexpr int CPR = ROWB / 16, TOTAL = 64 * CPR;
#pragma unroll
    for (int c = 0; c < TOTAL / 512; ++c) { const int idx = tid + c * 512, row = idx / CPR, ch = idx % CPR;
        const u32x4 v = *(const u32x4*)(gsrc + (size_t)row * gpitch_el + ch * 8);
        *(LAS u32x4*)(dst + row * lpitch + ch * 16) = v; }
}
__device__ __forceinline__ void attn_tile128(const LAS unsigned char* Kt, const LAS unsigned char* Vt, const bf16x8 (&qf)[4], f32x16 (&o)[2], float& m_run, float& l_run,
                                             const float c1, const float c2, const unsigned mA0, const unsigned mA1, const unsigned mB0, const unsigned mB1,
                                             const f32x16& kb0, const f32x16& kb1, const int lane) {
    constexpr int KP = 144, VP = 192;
    const int r32 = lane & 31, hi = lane >> 5;
    const LAS unsigned char* kp = Kt + r32 * KP + hi * 16;
    f32x16 p0, p1, p2, p3;
    { const bf16x8 qv = qf[0];
      p0 = __builtin_amdgcn_mfma_f32_32x32x16_bf16(*(const LAS bf16x8*)(kp), qv, kb0, 0, 0, 0); p1 = __builtin_amdgcn_mfma_f32_32x32x16_bf16(*(const LAS bf16x8*)(kp + 32 * KP), qv, kb1, 0, 0, 0);
      p2 = __builtin_amdgcn_mfma_f32_32x32x16_bf16(*(const LAS bf16x8*)(kp + 64 * KP), qv, kb0, 0, 0, 0); p3 = __builtin_amdgcn_mfma_f32_32x32x16_bf16(*(const LAS bf16x8*)(kp + 96 * KP), qv, kb1, 0, 0, 0); }
#pragma unroll
    for (int ks = 1; ks < 4; ++ks) { const bf16x8 qv = qf[ks];
        p0 = __builtin_amdgcn_mfma_f32_32x32x16_bf16(*(const LAS bf16x8*)(kp + ks * 32), qv, p0, 0, 0, 0); p1 = __builtin_amdgcn_mfma_f32_32x32x16_bf16(*(const LAS bf16x8*)(kp + 32 * KP + ks * 32), qv, p1, 0, 0, 0);
        p2 = __builtin_amdgcn_mfma_f32_32x32x16_bf16(*(const LAS bf16x8*)(kp + 64 * KP + ks * 32), qv, p2, 0, 0, 0); p3 = __builtin_amdgcn_mfma_f32_32x32x16_bf16(*(const LAS bf16x8*)(kp + 96 * KP + ks * 32), qv, p3, 0, 0, 0); }
#pragma unroll
    for (int r = 0; r < 16; ++r) { const int cp = (r & 3) + 8 * (r >> 2);
        const unsigned t0 = (unsigned)__builtin_amdgcn_sbfe((int)mA0, cp, 1), t1 = (unsigned)__builtin_amdgcn_sbfe((int)mA1, cp, 1), t2 = (unsigned)__builtin_amdgcn_sbfe((int)mB0, cp, 1), t3 = (unsigned)__builtin_amdgcn_sbfe((int)mB1, cp, 1);
        p0[r] = __uint_as_float((__float_as_uint(p0[r]) & t0) | (0xff800000u & ~t0)); p1[r] = __uint_as_float((__float_as_uint(p1[r]) & t1) | (0xff800000u & ~t1));
        p2[r] = __uint_as_float((__float_as_uint(p2[r]) & t2) | (0xff800000u & ~t2)); p3[r] = __uint_as_float((__float_as_uint(p3[r]) & t3) | (0xff800000u & ~t3)); }
    asm volatile("s_nop 15\n\ts_nop 7" : "+v"(p0), "+v"(p1), "+v"(p2), "+v"(p3));
    const float dB = 64.f * c2;
    float mx;
    { float a = fmax3_(p0[0], p0[1], p1[0]), b = fmax3_(p2[0], p2[1], p3[0]); a = fmax3_(a, p0[2], p0[3]); b = fmax3_(b, p2[2], p2[3]); a = fmax3_(a, p1[1], p1[2]); b = fmax3_(b, p3[1], p3[2]); a = fmax2_(a, p1[3]); b = fmax2_(b, p3[3]);
#pragma unroll
      for (int r = 4; r < 16; r += 4) { a = fmax3_(a, p0[r], p0[r + 1]); b = fmax3_(b, p2[r], p2[r + 1]); a = fmax3_(a, p0[r + 2], p0[r + 3]); b = fmax3_(b, p2[r + 2], p2[r + 3]);
          a = fmax3_(a, p1[r], p1[r + 1]); b = fmax3_(b, p3[r], p3[r + 1]); a = fmax3_(a, p1[r + 2], p1[r + 3]); b = fmax3_(b, p3[r + 2], p3[r + 3]); }
      const auto ra = __builtin_amdgcn_permlane32_swap(__float_as_uint(a), __float_as_uint(a), false, false);
      const auto rb = __builtin_amdgcn_permlane32_swap(__float_as_uint(b), __float_as_uint(b), false, false);
      a = fmax2_(__uint_as_float(ra[0]), __uint_as_float(ra[1])); b = fmax2_(__uint_as_float(rb[0]), __uint_as_float(rb[1]));
      mx = fmaxf(a * c1, b * c1 - dB); }
    if (__any(mx > m_run)) {
        const float mnew = fmaxf(m_run, mx);
        const float alpha = fexp2(m_run - mnew);
        m_run = mnew; l_run *= alpha;
#pragma unroll
        for (int e = 0; e < 2; ++e)
#pragma unroll
            for (int r = 0; r < 16; ++r) o[e][r] *= alpha;
    }
    const float nmA = -m_run, nmB = -m_run - dB;
#pragma unroll
    for (int r = 0; r < 16; ++r) { p0[r] = fexp2(__builtin_fmaf(p0[r], c1, nmA)); p1[r] = fexp2(__builtin_fmaf(p1[r], c1, nmA)); p2[r] = fexp2(__builtin_fmaf(p2[r], c1, nmB)); p3[r] = fexp2(__builtin_fmaf(p3[r], c1, nmB)); }
    { float s0 = (p0[0] + p1[0]) + (p2[0] + p3[0]), s1 = (p0[1] + p1[1]) + (p2[1] + p3[1]), s2 = (p0[2] + p1[2]) + (p2[2] + p3[2]), s3 = (p0[3] + p1[3]) + (p2[3] + p3[3]);
#pragma unroll
      for (int r = 4; r < 16; r += 4) { s0 += (p0[r] + p1[r]) + (p2[r] + p3[r]); s1 += (p0[r + 1] + p1[r + 1]) + (p2[r + 1] + p3[r + 1]); s2 += (p0[r + 2] + p1[r + 2]) + (p2[r + 2] + p3[r + 2]); s3 += (p0[r + 3] + p1[r + 3]) + (p2[r + 3] + p3[r + 3]); }
      l_run += (s0 + s1) + (s2 + s3); }
    const int g = lane >> 4, i16 = lane & 15;
    const LAS unsigned char* vp = Vt + (4 * hi + (i16 >> 2)) * VP + ((g & 1) * 16 + 4 * (i16 & 3)) * 2;
#pragma unroll
    for (int half = 0; half < 2; ++half) {
        const f32x16& q0 = half ? p2 : p0; const f32x16& q1 = half ? p3 : p1;
        u32x4 pw[4];
#pragma unroll
        for (int i = 0; i < 4; ++i) { pw[0][i] = cvt_pk_bf16(q0[2 * i], q0[2 * i + 1]); pw[1][i] = cvt_pk_bf16(q0[8 + 2 * i], q0[8 + 2 * i + 1]);
                                      pw[2][i] = cvt_pk_bf16(q1[2 * i], q1[2 * i + 1]); pw[3][i] = cvt_pk_bf16(q1[8 + 2 * i], q1[8 + 2 * i + 1]); }
        const LAS unsigned char* vh = vp + half * 64 * VP;
#pragma unroll
        for (int sI = 0; sI < 4; ++sI) { const bf16x8 pa = __builtin_bit_cast(bf16x8, pw[sI]);
#pragma unroll
            for (int e = 0; e < 2; ++e) { const s16x4 lo = vtr(vh + (16 * sI) * VP + e * 64), hh = vtr(vh + (16 * sI + 8) * VP + e * 64);
                const bf16x8 vf = (bf16x8){lo[0], lo[1], lo[2], lo[3], hh[0], hh[1], hh[2], hh[3]};
                o[e] = __builtin_amdgcn_mfma_f32_32x32x16_bf16(vf, pa, o[e], 0, 0, 0); } }
    }
}
template <int NE>
__device__ __forceinline__ void store_ot(const f32x16 (&o)[NE], float scale, bf16_t* rowp, int hi) {
#pragma unroll
    for (int e = 0; e < NE; ++e)
#pragma unroll
        for (int g4 = 0; g4 < 4; ++g4) { u32x2 w; w.x = cvt_pk_bf16(o[e][4 * g4] * scale, o[e][4 * g4 + 1] * scale); w.y = cvt_pk_bf16(o[e][4 * g4 + 2] * scale, o[e][4 * g4 + 3] * scale);
            *(u32x2*)(rowp + 32 * e + 8 * g4 + 4 * hi) = w; }
}

template <int NE>
__device__ __forceinline__ void store_ot8(const f32x16 (&o)[NE], float scale, unsigned char* rowp, int hi) {
#pragma unroll
    for (int e = 0; e < NE; ++e)
#pragma unroll
        for (int g4 = 0; g4 < 4; ++g4) *(unsigned*)(rowp + 32 * e + 8 * g4 + 4 * hi) = pack4_fp8(o[e][4 * g4] * scale, o[e][4 * g4 + 1] * scale, o[e][4 * g4 + 2] * scale, o[e][4 * g4 + 3] * scale);
}
template <int NE>
__device__ __forceinline__ void rows_out8(const LAS unsigned char* scr, unsigned char* grow0, const size_t gpitch, const int lane) {
    constexpr int PITCH = 32 * NE + 16, CH = 2 * NE, RPI = 64 / CH;
    const int rr = lane / CH, ch = lane % CH;
#pragma unroll
    for (int it = 0; it < 32 / RPI; ++it) { const int row = it * RPI + rr;
        const u32x4 v = *(const LAS u32x4*)(scr + row * PITCH + ch * 16); *(u32x4*)(grow0 + (size_t)row * gpitch + ch * 16) = v; }
}
template <int NE>
__device__ __forceinline__ void store_ot8_rows(const f32x16 (&o)[NE], float scale, LAS unsigned char* scr, unsigned char* grow0, const size_t gpitch, const int lane) {
    constexpr int PITCH = 32 * NE + 16; const int r32 = lane & 31, hi = lane >> 5;
#pragma unroll
    for (int e = 0; e < NE; ++e)
#pragma unroll
        for (int g4 = 0; g4 < 4; ++g4) *(LAS unsigned*)(scr + r32 * PITCH + 32 * e + 8 * g4 + 4 * hi) = pack4_fp8(o[e][4 * g4] * scale, o[e][4 * g4 + 1] * scale, o[e][4 * g4 + 2] * scale, o[e][4 * g4 + 3] * scale);
    rows_out8<NE>(scr, grow0, gpitch, lane);
}
__device__ __forceinline__ void make_kb(f32x16& kb0, f32x16& kb1, float c1, float c2, int hi) {
#pragma unroll
    for (int r = 0; r < 16; ++r) { kb0[r] = c2 * (float)((r & 3) + 8 * (r >> 2) + 4 * hi) / c1; kb1[r] = kb0[r] + 32.f * c2 / c1; }
}

__device__ __forceinline__ void diffattn_unit(const bf16_t* proj, unsigned char* ya, const float* subln, const float lam, const int b, const int h, const int qb,
                                              LAS unsigned char* lds, const int tid_in) {
    int tid = tid_in; asm volatile("" : "+v"(tid));
    const int wave = __builtin_amdgcn_readfirstlane(tid >> 6), lane = tid & 63, r32 = lane & 31, hi = lane >> 5;
    const int sb = wave & 3, mm = wave >> 2;
    const LAS float* subl = (const LAS float*)(lds + 131072); (void)subln;
    const int t0 = qb * 128 + sb * 32;
    const size_t rowbase = (size_t)b * SEQ;
    bf16x8 qf[4];
    { const bf16_t* qp = proj + (rowbase + t0 + r32) * PW + C_QA + h * 128 + mm * 64 + hi * 8;
#pragma unroll
      for (int ks = 0; ks < 4; ++ks) qf[ks] = *(const bf16x8*)(qp + ks * 16); }
    f32x16 o[4];
#pragma unroll
    for (int e = 0; e < 4; ++e)
#pragma unroll
        for (int r = 0; r < 16; ++r) o[e][r] = 0.f;
    float m_run = -1e30f, l_run = 0.f;
    const int nt = 2 * qb + 2, ntw = (t0 >> 6) + 1;
    constexpr int KP = 272, VP = 320, KB = 64 * KP, BUFB = 64 * KP + 64 * VP;
    const float c2 = exp2f(-2.f * (float)(h + 1)) * LOG2E;
    TileSc sf; sf.c1 = 0.125f * LOG2E; sf.c2 = c2; sf.fh = (float)(4 * hi); sf.tt = 2.f * c2 * (float)((t0 & 63) + r32); sf.m0 = 0u; sf.m1 = 0u; sf.diag = false;
    const bf16_t* src = proj + rowbase * PW + h * 128;
    TileRegs<256> kr, vr;
    { const bf16_t* s0 = src + (size_t)(64 * (nt - 1)) * PW; tile_load<256>(kr, s0 + C_KA, PW, tid); tile_load<256>(vr, s0 + C_VA, PW, tid); }
    tile_store<256>(kr, lds, KP, tid); tile_store<256>(vr, lds + KB, VP, tid);
#pragma unroll
    for (int ks = 0; ks < 4; ++ks) asm volatile("" : "+v"(qf[ks]));
    __syncthreads();
    for (int it = 0; it < nt; ++it) {
        const int j = nt - 1 - it;
        LAS unsigned char* kb = lds + (it & 1) * BUFB; LAS unsigned char* nb = lds + ((it + 1) & 1) * BUFB;
        if (j > 0) { const bf16_t* sn = src + (size_t)(64 * (j - 1)) * PW; tile_load<256>(kr, sn + C_KA, PW, tid); tile_load<256>(vr, sn + C_VA, PW, tid); }
        if (j < ntw) { sf.diag = (j == ntw - 1);
            float kq = c2 / sf.c1; asm volatile("" : "+v"(kq));
            const float kh = kq * sf.fh;
            f32x16 kb0, kb1;
#pragma unroll
            for (int r = 0; r < 16; ++r) { kb0[r] = kq * (float)((r & 3) + 8 * (r >> 2)) + kh; kb1[r] = kq * (float)((r & 3) + 8 * (r >> 2) + 32) + kh; }
            attn_tile<64, 128, true, true, false>(kb + mm * 128, KP, kb + KB, VP, QReg<4>{qf}, o, m_run, l_run, sf, kb0, kb1, lane); m_run += 64.f * c2; }
        if (j > 0) { tile_store<256>(kr, nb, KP, tid); tile_store<256>(vr, nb + KB, VP, tid); }
        __syncthreads();
    }
    const float ltot = xor32_sum(l_run);
    const float inv = 1.f / ltot;
    LAS float* X = (LAS float*)lds + sb * 4096;
    if (mm == 1) {
#pragma unroll
        for (int e = 0; e < 4; ++e)
#pragma unroll
            for (int r = 0; r < 16; ++r) X[(32 * e + crow(r, hi)) * 32 + r32] = o[e][r] * inv;
    }
    __syncthreads();
    if (mm == 0) {
        float ss = 0.f;
#pragma unroll
        for (int e = 0; e < 4; ++e) {
#pragma unroll
            for (int r = 0; r < 16; ++r) { const float d = o[e][r] * inv - lam * X[(32 * e + crow(r, hi)) * 32 + r32]; o[e][r] = d; ss += d * d; }
            __builtin_amdgcn_sched_barrier(0);
        }
        ss = xor32_sum(ss);
        const float rn = rsqrtf(ss * (1.f / 128.f) + EPS) * 0.8f * 4.f;
        LAS unsigned char* scr = (LAS unsigned char*)X;
#pragma unroll
        for (int e = 0; e < 4; ++e) {
#pragma unroll
            for (int g4 = 0; g4 < 4; ++g4) { const f32x4 sv = *(const LAS f32x4*)(subl + 32 * e + 8 * g4 + 4 * hi);
                *(LAS unsigned*)(scr + r32 * 144 + 32 * e + 8 * g4 + 4 * hi) = pack4_fp8(o[e][4 * g4] * rn * sv[0], o[e][4 * g4 + 1] * rn * sv[1], o[e][4 * g4 + 2] * rn * sv[2], o[e][4 * g4 + 3] * rn * sv[3]); }
            __builtin_amdgcn_sched_barrier(0);
        }
        rows_out8<4>(scr, ya + (rowbase + t0) * 1024 + h * 128, 1024, lane);
    }
    __syncthreads();
}

__device__ __forceinline__ unsigned f32_to_sortable16(float x) {
    const _Float16 hx = (_Float16)x; const unsigned b = (unsigned)__builtin_bit_cast(unsigned short, hx);
    return (b & 0x8000u) ? (~b & 0xffffu) : (b | 0x8000u);
}
__device__ __forceinline__ unsigned pk_count_gt(unsigned cnt, unsigned x, unsigned c) {
    unsigned d;
    asm("v_pk_sub_u16 %0, %1, %2 clamp" : "=v"(d) : "v"(x), "v"(c));
    asm("v_pk_min_u16 %0, %1, 1 op_sel_hi:[1,0]" : "=v"(d) : "v"(d));
    asm("v_pk_add_u16 %0, %1, %2" : "=v"(cnt) : "v"(cnt), "v"(d));
    return cnt;
}
__device__ __forceinline__ unsigned pk_wrapsum(unsigned acc, unsigned x, unsigned c2) {
    unsigned d;
    asm("v_pk_sub_u16 %0, %1, %2" : "=v"(d) : "v"(c2), "v"(x));
    asm("v_sad_u16 %0, %1, 0, %2" : "=v"(acc) : "v"(d), "v"(acc));
    return acc;
}
__device__ __forceinline__ unsigned nib_gt(unsigned x, unsigned y, unsigned c2) {
    unsigned gx, gy;
    asm("v_pk_sub_u16 %0, %1, %2 clamp" : "=v"(gx) : "v"(x), "v"(c2)); asm("v_pk_min_u16 %0, %1, 1 op_sel_hi:[1,0]" : "=v"(gx) : "v"(gx));
    asm("v_pk_sub_u16 %0, %1, %2 clamp" : "=v"(gy) : "v"(y), "v"(c2)); asm("v_pk_min_u16 %0, %1, 1 op_sel_hi:[1,0]" : "=v"(gy) : "v"(gy));
    return __builtin_amdgcn_udot4(__builtin_amdgcn_perm(gy, gx, 0x06040200u), 0x08040201u, 0u, false);
}
__device__ __forceinline__ int grp16_sum(int v) {
    v += __builtin_amdgcn_update_dpp(0, v, 0x128, 0xf, 0xf, false);
    v += __builtin_amdgcn_update_dpp(0, v, 0x124, 0xf, 0xf, false);
    v += __builtin_amdgcn_update_dpp(0, v, 0x122, 0xf, 0xf, false);
    v += __builtin_amdgcn_update_dpp(0, v, 0x121, 0xf, 0xf, false);
    return v;
}
__device__ __forceinline__ int grp16_incl_scan(int v) {
    v += __builtin_amdgcn_update_dpp(0, v, 0x111, 0xf, 0xf, true);
    v += __builtin_amdgcn_update_dpp(0, v, 0x112, 0xf, 0xf, true);
    v += __builtin_amdgcn_update_dpp(0, v, 0x114, 0xf, 0xf, true);
    v += __builtin_amdgcn_update_dpp(0, v, 0x118, 0xf, 0xf, true);
    return v;
}

__device__ __forceinline__ void dsa_unit(const bf16_t* proj, unsigned char* yb, const int b, const int qblk, LAS unsigned char* lds, const int tid_in) {
    int tid = tid_in; asm volatile("" : "+v"(tid));
    const int wave = __builtin_amdgcn_readfirstlane(tid >> 6), lane = tid & 63, r32 = lane & 31, hi = lane >> 5;
    const int t0 = qblk * 32, nt = (t0 >> 6) + 1;
    const size_t rowbase = (size_t)b * SEQ;
    const bool need_sel = nt > 4;
    LAS unsigned* mask = (LAS unsigned*)(lds + MASK_OFF);
    bf16x8 qf[4]; TileRegs<128> kr, vr;
#define DSA_FIRST_LOADS() do { const bf16_t* qp_ = proj + (rowbase + t0 + r32) * PW + C_QB + wave * 64 + hi * 8; \
        _Pragma("unroll") for (int ks = 0; ks < 4; ++ks) qf[ks] = *(const bf16x8*)(qp_ + ks * 16); \
        const bf16_t* s0_ = proj + rowbase * PW + (size_t)(64 * (nt - 1)) * PW; tile_load<128>(kr, s0_ + C_KB, PW, tid); tile_load<128>(vr, s0_ + C_VB, PW, tid); } while (0)
    if (!need_sel) DSA_FIRST_LOADS();
    if (need_sel) for (int rep2_ = 0; rep2_ < REPS(102); ++rep2_) {
        for (int i = tid; i < 32 * MASK_PITCH_W; i += 512) mask[i] = 0u;
        const int rs8 = (nt | 1) * 8; const float inv_nt = 1.f / (float)nt;
        {
            bf16x8 qi[4][4]; float w[4];
            const bf16_t* qrow = proj + (rowbase + t0 + r32) * PW;
            LAS unsigned char* QI = lds + QIDX_OFF;
            { const bf16_t* qsrc = proj + (rowbase + t0) * PW + C_QI;
#pragma unroll
              for (int c = 0; c < 2; ++c) { const int idx = tid + c * 512, row = idx >> 5, ch = idx & 31;
                  const u32x4 v = *(const u32x4*)(qsrc + (size_t)row * PW + ch * 8); *(LAS u32x4*)(QI + row * 528 + ch * 16) = v; } }
#pragma unroll
            for (int hh = 0; hh < 4; ++hh) w[hh] = bf2f(qrow[C_WI + hh]) * 0.0625f;
            __syncthreads();
#pragma unroll
            for (int hh = 0; hh < 4; ++hh)
#pragma unroll
                for (int ks = 0; ks < 4; ++ks) qi[hh][ks] = *(const LAS bf16x8*)(QI + r32 * 528 + (hh * 64 + ks * 16 + hi * 8) * 2);
            const bf16_t* kbase = proj + (rowbase + r32) * PW + C_KI + hi * 8;
            bf16x8 kf[4], kn[4];
            if (wave < 2 * nt) {
#pragma unroll
                for (int ks = 0; ks < 4; ++ks) kf[ks] = *(const bf16x8*)(kbase + (size_t)(32 * wave) * PW + ks * 16); }
#pragma unroll 1
            for (int it = wave; it < 2 * nt; it += 8) {
                const int j = it >> 1, blk = it & 1; const int nx = (it + 8 < 2 * nt) ? it + 8 : it;
#pragma unroll
                for (int ks = 0; ks < 4; ++ks) kn[ks] = *(const bf16x8*)(kbase + (size_t)(32 * nx) * PW + ks * 16);
                f32x16 isc;
#pragma unroll
                for (int r = 0; r < 16; ++r) isc[r] = 0.f;
#pragma unroll
                for (int hh = 0; hh < 4; ++hh) { f32x16 a;
#pragma unroll
                    for (int r = 0; r < 16; ++r) a[r] = 0.f;
#pragma unroll
                    for (int ks = 0; ks < 4; ++ks) a = __builtin_amdgcn_mfma_f32_32x32x16_bf16(kf[ks], qi[hh][ks], a, 0, 0, 0);
#pragma unroll
                    for (int r = 0; r < 16; ++r) isc[r] += w[hh] * fmaxf(a[r], 0.f); }
#pragma unroll
                for (int g4 = 0; g4 < 4; ++g4) {
                    const unsigned u0 = f32_to_sortable16(isc[4 * g4]), u1 = f32_to_sortable16(isc[4 * g4 + 1]), u2 = f32_to_sortable16(isc[4 * g4 + 2]), u3 = f32_to_sortable16(isc[4 * g4 + 3]);
                    const int kq = 16 * j + 8 * blk + 2 * g4 + hi;
                    const int rg = (int)(((float)kq + 0.5f) * inv_nt);
                    u32x2 w2; w2.x = u0 | (u1 << 16); w2.y = u2 | (u3 << 16);
                    *(LAS u32x2*)(lds + r32 * ISC_PITCH + rg * rs8 + (kq - rg * nt) * 8) = w2;
                }
#pragma unroll
                for (int ks = 0; ks < 4; ++ks) kf[ks] = kn[ks];
            }
        }
        DSA_FIRST_LOADS();
        __syncthreads();
        {
            const int q = tid >> 4, sub = tid & 15;
            const LAS unsigned char* base = lds + q * ISC_PITCH + sub * rs8;
            u32x2 v[32];
#pragma unroll
            for (int i = 0; i < 32; ++i) { if (i < nt) v[i] = *(const LAS u32x2*)(base + 8 * i); else { v[i].x = 0u; v[i].y = 0u; } }
            unsigned T = 0u;
            int xtot, xthr;
            { unsigned xs = 0u;
#pragma unroll
              for (int i = 0; i < 32; ++i) if (i < nt) { asm("v_sad_u16 %0, %1, 0, %2" : "=v"(xs) : "v"(v[i].x), "v"(xs)); asm("v_sad_u16 %0, %1, 0, %2" : "=v"(xs) : "v"(v[i].y), "v"(xs)); }
              xthr = (int)xs; xtot = grp16_sum((int)xs); }
            const int ntot = 64 * nt;
            {
                unsigned tb[32];
#pragma unroll
                for (int i = 0; i < 32; ++i) tb[i] = (i < nt) ? __builtin_amdgcn_perm(v[i].y, v[i].x, 0x07050301u) : 0u;
                unsigned Th = 0u;
                for (int bit = 7; bit >= 0; --bit) {
                    const unsigned ch = Th | (1u << bit); const unsigned c4 = ch * 0x01010101u, m4 = (ch - 1u) * 0x01010101u; unsigned a1 = 0u, a2 = 0u;
#pragma unroll
                    for (int i = 0; i < 32; ++i) if (i < nt) { asm("v_sad_u8 %0, %1, %2, %3" : "=v"(a1) : "v"(tb[i]), "v"(m4), "v"(a1)); asm("v_sad_u8 %0, %1, %2, %3" : "=v"(a2) : "v"(tb[i]), "v"(c4), "v"(a2)); }
                    const int cnt = (ntot + grp16_sum((int)a1 - (int)a2)) >> 1;
                    if (cnt >= 256) Th = ch;
                }
                const unsigned th2 = (Th << 8) * 0x10001u;
#pragma unroll
                for (int i = 0; i < 32; ++i) if (i < nt) { unsigned zx, zy;
                    asm("v_pk_sub_u16 %0, %1, %2 clamp" : "=v"(zx) : "v"(v[i].x), "v"(th2)); asm("v_pk_min_u16 %0, %1, %2" : "=v"(zx) : "v"(zx), "v"(0x00ff00ffu));
                    asm("v_pk_sub_u16 %0, %1, %2 clamp" : "=v"(zy) : "v"(v[i].y), "v"(th2)); asm("v_pk_min_u16 %0, %1, %2" : "=v"(zy) : "v"(zy), "v"(0x00ff00ffu));
                    tb[i] = __builtin_amdgcn_perm(zy, zx, 0x06040200u); }
                unsigned Tl = 0u;
                for (int bit = 7; bit >= 0; --bit) {
                    const unsigned cl = Tl | (1u << bit); const unsigned c4 = cl * 0x01010101u, m4 = (cl - 1u) * 0x01010101u; unsigned a1 = 0u, a2 = 0u;
#pragma unroll
                    for (int i = 0; i < 32; ++i) if (i < nt) { asm("v_sad_u8 %0, %1, %2, %3" : "=v"(a1) : "v"(tb[i]), "v"(m4), "v"(a1)); asm("v_sad_u8 %0, %1, %2, %3" : "=v"(a2) : "v"(tb[i]), "v"(c4), "v"(a2)); }
                    const int cnt = (ntot + grp16_sum((int)a1 - (int)a2)) >> 1;
                    if (cnt >= 256) Tl = cl;
                }
                T = (Th << 8) | Tl;
            }
            int cgt, ceq;
            { unsigned sg = 0u, se = 0u; const unsigned tp = T * 0x10001u, tm1 = (T - 1u) * 0x10001u;
#pragma unroll
              for (int i = 0; i < 32; ++i) if (i < nt) { sg = pk_wrapsum(sg, v[i].x, tp); sg = pk_wrapsum(sg, v[i].y, tp); se = pk_wrapsum(se, v[i].x, tm1); se = pk_wrapsum(se, v[i].y, tm1); }
              cgt = ((int)sg - 4 * nt * (int)T + xthr) >> 16; ceq = (((int)se - 4 * nt * ((int)T - 1) + xthr) >> 16) - cgt; }
            const int need = 256 - grp16_sum(cgt);
            int rem = need - (grp16_incl_scan(ceq) - ceq);
            LAS unsigned* mrow = mask + q * MASK_PITCH_W;
            const unsigned tp2 = T * 0x10001u, tm2 = (T - 1u) * 0x10001u;
#pragma unroll
            for (int i = 0; i < 32; ++i) if (i < nt) {
                const unsigned gt = nib_gt(v[i].x, v[i].y, tp2), eqn = nib_gt(v[i].x, v[i].y, tm2) ^ gt;
                unsigned nib = gt;
                if (__any(eqn != 0u)) {
                    unsigned t = eqn;
#pragma unroll
                    for (int e = 0; e < 4; ++e) { const unsigned low = t & (0u - t); nib |= (rem > 0) ? low : 0u; rem -= (low != 0u) ? 1 : 0; t ^= low; }
                }
                const int pos = sub * nt + i;
                if (nib) atomicOr((unsigned*)(mrow + (pos >> 3)), nib << ((pos & 7) * 4));
            }
        }
        __syncthreads();
    }
#undef DSA_FIRST_LOADS
    f32x16 o[2];
#pragma unroll
    for (int e = 0; e < 2; ++e)
#pragma unroll
        for (int r = 0; r < 16; ++r) o[e][r] = 0.f;
    float m_run = -1e30f, l_run = 0.f;
    constexpr int KP = 144, VP = 192, KB = 128 * KP, STG = 128 * KP + 128 * VP;
    const float c2 = exp2f(-(float)(wave + 1)) * LOG2E;
    TileSc sf; sf.c1 = 0.125f * LOG2E; sf.c2 = c2; sf.fh = (float)(4 * hi); sf.tt = 2.f * c2 * (float)((t0 & 63) + r32); sf.m0 = 0xffffffffu; sf.m1 = 0xffffffffu; sf.diag = false;
    f32x16 kb0, kb1; make_kb(kb0, kb1, sf.c1, c2, hi);
    const bf16_t* src = proj + rowbase * PW;
    tile_store<128>(kr, lds, KP, tid); tile_store<128>(vr, lds + KB, VP, tid);
#pragma unroll
    for (int ks = 0; ks < 4; ++ks) asm volatile("" : "+v"(qf[ks]));
    __syncthreads();
    TileRegs<128> kr2, vr2;
    int jc = nt - 1, nc = 1;
    for (int st = 0; jc >= 0; ++st) {
        const int jn = jc - nc, nn = (jn >= 1) ? 2 : (jn == 0 ? 1 : 0);
        LAS unsigned char* cb = lds + (st & 1) * STG; LAS unsigned char* nb = lds + ((st + 1) & 1) * STG;
        if (nn >= 1) { const bf16_t* sn = src + (size_t)(64 * jn) * PW; tile_load<128>(kr, sn + C_KB, PW, tid); tile_load<128>(vr, sn + C_VB, PW, tid); }
        if (nn == 2) { const bf16_t* sn = src + (size_t)(64 * (jn - 1)) * PW; tile_load<128>(kr2, sn + C_KB, PW, tid); tile_load<128>(vr2, sn + C_VB, PW, tid); }
        if (nc == 2) {
            unsigned a0 = 0xffffffffu, a1 = 0xffffffffu, b0 = 0xffffffffu, b1 = 0xffffffffu;
            if (need_sel) { const u32x2 mwa = *(const LAS u32x2*)(mask + r32 * MASK_PITCH_W + 2 * jc), mwb = *(const LAS u32x2*)(mask + r32 * MASK_PITCH_W + 2 * (jc - 1));
                a0 = mwa.x >> (4 * hi); a1 = mwa.y >> (4 * hi); b0 = mwb.x >> (4 * hi); b1 = mwb.y >> (4 * hi); }
            attn_tile128(cb, cb + KB, qf, o, m_run, l_run, sf.c1, c2, a0, a1, b0, b1, kb0, kb1, lane); m_run += 128.f * c2;
        } else {
            if (need_sel) { const u32x2 mw = *(const LAS u32x2*)(mask + r32 * MASK_PITCH_W + 2 * jc); sf.m0 = mw.x >> (4 * hi); sf.m1 = mw.y >> (4 * hi); }
            sf.diag = (st == 0);
            attn_tile<64, 64, false, true, true>(cb, KP, cb + KB, VP, QReg<4>{qf}, o, m_run, l_run, sf, kb0, kb1, lane); m_run += 64.f * c2;
        }
        if (nn >= 1) { tile_store<128>(kr, nb, KP, tid); tile_store<128>(vr, nb + KB, VP, tid); }
        if (nn == 2) { tile_store<128>(kr2, nb + 64 * KP, KP, tid); tile_store<128>(vr2, nb + KB + 64 * VP, VP, tid); }
        __syncthreads();
        jc = jn; nc = nn;
    }
    const float ltot = xor32_sum(l_run);
    store_ot8_rows<2>(o, 8.f / ltot, lds + wave * 2560, yb + (rowbase + t0) * 1024 + wave * 64, 1024, lane);
    __syncthreads();
}

__device__ __forceinline__ void cross_unit(const bf16_t* qc, const bf16_t* kvc, unsigned char* oc, const int b, const int hx, const int qb, LAS unsigned char* lds, const int tid_in) {
    int tid = tid_in; asm volatile("" : "+v"(tid));
    const int wave = __builtin_amdgcn_readfirstlane(tid >> 6), lane = tid & 63, r32 = lane & 31, hi = lane >> 5;
    const int sb = wave & 3, eh = wave >> 2;
    const int t0 = qb * 128 + sb * 32;
    const size_t rowbase = (size_t)b * SEQ;
    constexpr int QP = 528, KP = 528, VP = 576, QB_ = 128 * QP, KB = 64 * KP;
    LAS unsigned char* Qs = lds; LAS unsigned char* Kt = lds + QB_; LAS unsigned char* Vt = Kt + KB;
    const bf16_t* src = kvc + (size_t)b * NMEM * 2048 + hx * 256;
    TileRegs<512> kr, vr;
    { const bf16_t* s0 = src + (size_t)(64 * (qb & 3)) * 2048; tile_load<512>(kr, s0, 2048, tid); tile_load<512>(vr, s0 + 1024, 2048, tid); }
    { const bf16_t* qsrc = qc + (rowbase + qb * 128) * 1024 + hx * 256;
#pragma unroll
      for (int c = 0; c < 8; ++c) { const int idx = tid + c * 512, row = idx >> 5, ch = idx & 31;
          const u32x4 v = *(const u32x4*)(qsrc + (size_t)row * 1024 + ch * 8); *(LAS u32x4*)(Qs + row * QP + ch * 16) = v; } }
    tile_store<512>(kr, Kt, KP, tid); tile_store<512>(vr, Vt, VP, tid);
    __syncthreads();
    f32x16 o[4];
#pragma unroll
    for (int e = 0; e < 4; ++e)
#pragma unroll
        for (int r = 0; r < 16; ++r) o[e][r] = 0.f;
    float m_run = -1e30f, l_run = 0.f;
    TileSc sf; sf.c1 = 0.0625f * LOG2E; sf.c2 = 0.f; sf.tt = 0.f; sf.fh = 0.f; sf.m0 = 0u; sf.m1 = 0u; sf.diag = false;
    f32x16 kbz;
#pragma unroll
    for (int r = 0; r < 16; ++r) kbz[r] = 0.f;
    const QLds ql{Qs + (sb * 32 + r32) * QP + hi * 16};
    for (int j = 0; j < 4; ++j) {
        if (j + 1 < 4) { const bf16_t* sn = src + (size_t)(64 * ((qb + j + 1) & 3)) * 2048; tile_load<512>(kr, sn, 2048, tid); tile_load<512>(vr, sn + 1024, 2048, tid); }
        attn_tile<256, 128, true, false, false>(Kt, KP, Vt + eh * 256, VP, ql, o, m_run, l_run, sf, kbz, kbz, lane);
        __syncthreads();
        if (j + 1 < 4) { tile_store<512>(kr, Kt, KP, tid); tile_store<512>(vr, Vt, VP, tid); __syncthreads(); }
    }
    const float ltot = xor32_sum(l_run);
    store_ot8_rows<4>(o, 16.f / ltot, lds + wave * 4608, oc + (rowbase + t0) * 1024 + hx * 256 + eh * 128, 1024, lane);
    __syncthreads();
}

__device__ __forceinline__ void moe_tables(const int* hist, LAS int* tab, const int tb_limit, const int tid) {
    const int e = tid & 31, part = tid >> 5;
    int tot = 0, pre = 0;
    for (int tb = part; tb < 256; tb += 16) { const int hv = hist[tb * 32 + e]; tot += hv; pre += (tb < tb_limit) ? hv : 0; }
    tab[128 + part * 32 + e] = tot; tab[1024 + part * 32 + e] = pre;
    __syncthreads();
    if (tid < 32) { int a = 0, p = 0;
#pragma unroll
        for (int k = 0; k < 16; ++k) { a += tab[128 + k * 32 + tid]; p += tab[1024 + k * 32 + tid]; }
        tab[tid] = a; tab[640 + tid] = p; }
    __syncthreads();
    if (tid == 0) { int ps = 0, rb = 0;
        for (int k = 0; k < 32; ++k) { tab[32 + k] = ps; tab[72 + k] = rb; const int nb = (tab[k] + 255) >> 8; ps += nb * 256; rb += nb; }
        tab[64] = ps; tab[104] = rb; tab[108] = rb; }
    __syncthreads();
    { const int n_rb = tab[108]; LAS unsigned char* rb2e = (LAS unsigned char*)(tab + 1600);
      for (int rb = tid; rb < n_rb; rb += 512) { int ee = 0;
#pragma unroll 4
          for (int k = 1; k < 32; ++k) ee += (rb >= tab[72 + k]) ? 1 : 0;
          rb2e[rb] = (unsigned char)ee; } }
    __syncthreads();
}

__device__ __forceinline__ void router_block(const bf16_t* h2, const bf16_t* wrh, LAS unsigned char* lds, const float* b_router, const float* b_group, const int tb,
                                             int* tok_e, float* tok_g, float* tok_inv, int* hist, LAS int* lhist, const int tid) {
    const int wave = __builtin_amdgcn_readfirstlane(tid >> 6), lane = tid & 63, r32 = lane & 31, hi = lane >> 5;
    if (tid < 32) lhist[tid] = 0;
    constexpr int RPB = 144, XTB = 32 * RPB, WTB = 64 * RPB;
    LAS unsigned char* XH = lds + wave * (2 * XTB); LAS unsigned char* XL = XH + XTB;
    LAS unsigned char* WT = lds + 8 * (2 * XTB);
    LAS float* SSX = (LAS float*)(WT + 4 * WTB) + wave * 32;
    for (int i = tid; i < 4 * WTB / 16; i += 512) *(LAS u32x4*)(WT + 16 * i) = (u32x4){0u, 0u, 0u, 0u};
    __syncthreads();
    const int tok0 = tb * 256 + wave * 32, tok = tok0 + r32;
    const bf16_t* xg = h2 + (size_t)(tok0 + (lane >> 4)) * 1024 + 4 * (lane & 15);
    const int wp0 = tid, wp1 = 512 + tid;
    u32x2 xr[8]; u32x4 wq0, wq1; float sq[8];
#pragma unroll
    for (int i = 0; i < 8; ++i) sq[i] = 0.f;
#define RT_WSRC(p_, c_) (wrh + (size_t)((p_) / 288) * (36 * 1024) + (size_t)(((p_) % 288) >> 3) * 1024 + 64 * (c_) + 8 * ((p_) & 7))
#define RT_WDST(p_, b_) (WT + (b_) * (2 * WTB) + ((p_) / 288) * WTB + (((p_) % 288) >> 3) * RPB + 16 * ((p_) & 7))
#define RT_LOAD(c_) do { _Pragma("unroll") for (int i_ = 0; i_ < 8; ++i_) xr[i_] = *(const u32x2*)(xg + (size_t)(4 * i_) * 1024 + 64 * (c_)); \
        wq0 = *(const u32x4*)RT_WSRC(wp0, c_); if (wp1 < 576) wq1 = *(const u32x4*)RT_WSRC(wp1, c_); } while (0)
#define RT_STORE(b_) do { _Pragma("unroll") for (int i_ = 0; i_ < 8; ++i_) { const u32x2 h_ = xr[i_]; const f32x4 v_ = (f32x4){bf_lo(h_.x), bf_hi(h_.x), bf_lo(h_.y), bf_hi(h_.y)}; \
            sq[i_] += (v_.x * v_.x + v_.y * v_.y) + (v_.z * v_.z + v_.w * v_.w); \
            const int off_ = (4 * i_ + (lane >> 4)) * RPB + 8 * (lane & 15); *(LAS u32x2*)(XH + off_) = h_; } \
        *(LAS u32x4*)RT_WDST(wp0, b_) = wq0; if (wp1 < 576) *(LAS u32x4*)RT_WDST(wp1, b_) = wq1; } while (0)
    f32x16 acc, acc2;
#pragma unroll
    for (int r = 0; r < 16; ++r) { acc[r] = 0.f; acc2[r] = 0.f; }
#pragma unroll 1
    for (int c = 0; c < 16; ++c) {
        RT_LOAD(c); RT_STORE(c & 1);
        __syncthreads();
        const LAS unsigned char* xh = XH + r32 * RPB + 16 * hi;
        const LAS unsigned char* wh = WT + (c & 1) * (2 * WTB) + r32 * RPB + 16 * hi; const LAS unsigned char* wl = wh + WTB;
#pragma unroll
        for (int ks = 0; ks < 4; ++ks) {
            const bf16x8 bxh = *(const LAS bf16x8*)(xh + 32 * ks);
            const bf16x8 a1h = *(const LAS bf16x8*)(wh + 32 * ks), a1l = *(const LAS bf16x8*)(wl + 32 * ks);
            const bf16x8 a2h = *(const LAS bf16x8*)(wh + 32 * RPB + 32 * ks), a2l = *(const LAS bf16x8*)(wl + 32 * RPB + 32 * ks);
            acc = __builtin_amdgcn_mfma_f32_32x32x16_bf16(a1l, bxh, acc, 0, 0, 0); acc = __builtin_amdgcn_mfma_f32_32x32x16_bf16(a1h, bxh, acc, 0, 0, 0);
            acc2 = __builtin_amdgcn_mfma_f32_32x32x16_bf16(a2l, bxh, acc2, 0, 0, 0); acc2 = __builtin_amdgcn_mfma_f32_32x32x16_bf16(a2h, bxh, acc2, 0, 0, 0);
        }
    }
#undef RT_LOAD
#undef RT_STORE
#undef RT_WSRC
#undef RT_WDST
#pragma unroll
    for (int i = 0; i < 8; ++i) { float v = sq[i];
        v += __builtin_bit_cast(float, __builtin_amdgcn_update_dpp(0, __builtin_bit_cast(int, v), 0x128, 0xf, 0xf, false));
        v += __builtin_bit_cast(float, __builtin_amdgcn_update_dpp(0, __builtin_bit_cast(int, v), 0x124, 0xf, 0xf, false));
        v += __builtin_bit_cast(float, __builtin_amdgcn_update_dpp(0, __builtin_bit_cast(int, v), 0x122, 0xf, 0xf, false));
        v += __builtin_bit_cast(float, __builtin_amdgcn_update_dpp(0, __builtin_bit_cast(int, v), 0x121, 0xf, 0xf, false));
        if ((lane & 15) == 0) SSX[4 * i + (lane >> 4)] = v; }
    __syncthreads();
    const float ss = SSX[r32];
    float gl[4];
#pragma unroll
    for (int g = 0; g < 4; ++g) gl[g] = hi ? 0.f : acc2[g];
    const float inv = rsqrtf(ss * (1.f / 1024.f) + EPS);
    float gmax = -INFINITY; int gi = 0;
#pragma unroll
    for (int g = 0; g < 4; ++g) { gl[g] = (gl[g] + __shfl_xor(gl[g], 32)) * inv + b_group[g]; if (gl[g] > gmax) { gmax = gl[g]; gi = g; } }
    float gz = 0.f;
#pragma unroll
    for (int g = 0; g < 4; ++g) gz += __expf(gl[g] - gmax);
    const float pg = 1.f / gz;
    float lv[4];
#pragma unroll
    for (int i = 0; i < 4; ++i) { float t = acc[i]; t = (gi == 1) ? acc[4 + i] : t; t = (gi == 2) ? acc[8 + i] : t; t = (gi == 3) ? acc[12 + i] : t;
        lv[i] = t * inv + b_router[8 * gi + 4 * hi + i]; }
    float e8[8];
#pragma unroll
    for (int i = 0; i < 4; ++i) { const float other = __shfl_xor(lv[i], 32); e8[i] = hi ? other : lv[i]; e8[4 + i] = hi ? lv[i] : other; }
    int i0 = 0; float l0 = e8[0];
#pragma unroll
    for (int i = 1; i < 8; ++i) if (e8[i] > l0) { l0 = e8[i]; i0 = i; }
    int i1 = -1; float l1 = -INFINITY;
#pragma unroll
    for (int i = 0; i < 8; ++i) if (i != i0 && e8[i] > l1) { l1 = e8[i]; i1 = i; }
    const float ex1 = __expf(l1 - l0), den = 1.f / (1.f + ex1);
    const int E0 = 8 * gi + i0, E1 = 8 * gi + i1;
    if (hi == 0) { tok_e[tok] = E0 | (E1 << 8); tok_g[2 * tok] = pg * den; tok_g[2 * tok + 1] = pg * ex1 * den; tok_inv[tok] = inv;
        atomicAdd((int*)(lhist + E0), 1); atomicAdd((int*)(lhist + E1), 1); }
    __syncthreads();
    if (tid < 32) hist[tb * 32 + tid] = lhist[tid];
    __syncthreads();
}

__device__ __forceinline__ int opaque_tid() { int t = threadIdx.x; asm volatile("" : "+v"(t)); return t; }
#define PHASE_IDS() const int tid = opaque_tid(); const int lane = tid & 63; const int wave = __builtin_amdgcn_readfirstlane(tid >> 6); (void)lane; (void)wave; DECL_PTRS()
enum { PH_PRO = 0, PH_PROJ, PH_MIX, PH_BRANCH, PH_OUT, PH_CQ, PH_CROSS, PH_CO, PH_ROUTE, PH_SLOT, PH_UP, PH_DOWN, PH_FINAL, N_PHASES };

struct Args { const float* in[28]; float* out; unsigned char* ws; int ph_lo, ph_hi; };

__global__ void __launch_bounds__(512, 2) fwd_kernel(Args args) {
    extern __shared__ __attribute__((aligned(16))) unsigned char lds_raw[];
    LAS unsigned char* lds = (LAS unsigned char*)lds_raw;
    const int tid = threadIdx.x, lane = tid & 63, wave = __builtin_amdgcn_readfirstlane(tid >> 6);
    const int G = gridDim.x, bx = blockIdx.x;
    unsigned char* ws = args.ws;
    volatile LAS unsigned* MISC = (volatile LAS unsigned*)(lds + MISC_OFF);
    LAS int* tab = (LAS int*)(lds + TAB_OFF);
    if (tid < 64) MISC[tid] = 0u;
    __syncthreads();
    const int lo = args.ph_lo, hi_ph = args.ph_hi;
    XcdBarrier bar; bar.bar = (unsigned*)(ws + WS_CTL) + CW_BAR; bar.x = 0; bar.st = MISC + 8;
    if (hi_ph - lo > 1) bar = xcd_barrier_post((unsigned*)(ws + WS_CTL) + CW_BAR, MISC + 8);
#define IN(k) (lo <= (k) && (k) < hi_ph)
#define SEAM(k) do { if (IN(k) && IN((k) + 1)) xcd_barrier(bar); } while (0)

#define KA_(T, off) (*(T const __attribute__((address_space(4)))*)(kp_ + (off)))
#define DECL_PTRS() const __attribute__((address_space(4))) char* kp_ = (const __attribute__((address_space(4))) char*)__builtin_amdgcn_kernarg_segment_ptr(); asm volatile("" : "+s"(kp_)); \
    const float* x = KA_(const float*, 8 * 0); const float* mem = KA_(const float*, 8 * 1); const float* mix_norm = KA_(const float*, 8 * 2); const float* w_in = KA_(const float*, 8 * 3); const float* lam_q1 = KA_(const float*, 8 * 4); const float* lam_k1 = KA_(const float*, 8 * 5); const float* lam_q2 = KA_(const float*, 8 * 6); const float* lam_k2 = KA_(const float*, 8 * 7); const float* diff_subln = KA_(const float*, 8 * 8); const float* w_branch_a = KA_(const float*, 8 * 9); const float* w_branch_b = KA_(const float*, 8 * 10); const float* w_gate = KA_(const float*, 8 * 11); const float* b_gate = KA_(const float*, 8 * 12); const float* w_out = KA_(const float*, 8 * 13); const float* cross_norm = KA_(const float*, 8 * 14); const float* mem_norm = KA_(const float*, 8 * 15); const float* w_cq = KA_(const float*, 8 * 16); const float* w_ckv = KA_(const float*, 8 * 17); const float* w_co = KA_(const float*, 8 * 18); const float* ffn_norm = KA_(const float*, 8 * 19); const float* w_group = KA_(const float*, 8 * 20); const float* b_group = KA_(const float*, 8 * 21); const float* w_router = KA_(const float*, 8 * 22); const float* b_router = KA_(const float*, 8 * 23); const float* w1 = KA_(const float*, 8 * 24); const float* w3 = KA_(const float*, 8 * 25); const float* w2 = KA_(const float*, 8 * 26); const float* final_norm = KA_(const float*, 8 * 27); float* out = KA_(float*, 224); unsigned char* ws = KA_(unsigned char*, 232); float* rowss = (float*)(ws + WS_ROWSS); int* tok_e = (int*)(ws + WS_TOKE); float* tok_g = (float*)(ws + WS_TOKG); int* hist = (int*)(ws + WS_HIST); bf16_t* wrh = (bf16_t*)(ws + WS_WRT); int* sdest = (int*)(ws + WS_SDEST); float* sgate = (float*)(ws + WS_SGATE); int* stok = (int*)(ws + WS_STOK); float* tok_inv = (float*)(ws + WS_TOKINV); float* siv = (float*)(ws + WS_SIV); unsigned char* W8 = ws + WS_WCAT; bf16_t* Wi = (bf16_t*)(ws + WS_WCAT + 5 * MiB); unsigned char* Wa = ws + WS_WA; unsigned char* Wb = ws + WS_WB; unsigned char* Wout = ws + WS_WOUT; unsigned char* Wcq = ws + WS_WCQ; unsigned char* Wckv = ws + WS_WCKV;  unsigned char* Wco = ws + WS_WCO; unsigned char* W13 = ws + WS_W13; unsigned char* W2 = ws + WS_W2; unsigned char* memn8 = ws + WS_MEMN; bf16_t* kvc = (bf16_t*)(ws + WS_KVC); bf16_t* xn = (bf16_t*)(ws + WS_R1); bf16_t* merged = xn; unsigned char* xn2_8 = ws + WS_R1; unsigned char* merged8 = ws + WS_R2; unsigned char* xn8 = ws + WS_R4; unsigned char* hb3 = ws + WS_R1; bf16_t* proj = (bf16_t*)(ws + WS_R2); bf16_t* qc = proj; unsigned char* oc = ws + WS_R2 + (size_t)NTOK * 1024 * 2; bf16_t* xs = proj; unsigned char* gates = ws + WS_R3; unsigned char* y2 = ws + WS_R3; unsigned char* ya = ws + WS_R4; unsigned char* yb = ya + 512; unsigned char* hmid = ws + WS_R4; bf16_t* h1b = (bf16_t*)out; bf16_t* h2b = (bf16_t*)(ws + WS_R2 + 192 * MiB); \
    (void)x; (void)mem; (void)mix_norm; (void)w_in; (void)lam_q1; (void)lam_k1; (void)lam_q2; (void)lam_k2; (void)diff_subln; (void)w_branch_a; (void)w_branch_b; (void)w_gate; (void)b_gate; (void)w_out; \
    (void)cross_norm; (void)mem_norm; (void)w_cq; (void)w_ckv; (void)w_co; (void)ffn_norm; (void)w_group; (void)b_group; (void)w_router; (void)b_router; (void)w1; (void)w3; (void)w2; (void)final_norm; (void)out; \
    (void)rowss; (void)tok_e; (void)tok_g; (void)hist; (void)wrh; (void)sdest; (void)sgate; (void)W8; (void)Wi; (void)Wa; (void)Wb; (void)Wout; (void)Wcq; (void)Wckv; (void)Wco; (void)W13; (void)W2; (void)memn8; (void)merged8; (void)xn8; (void)xn2_8; (void)kvc; \
    (void)stok; (void)tok_inv; (void)siv; (void)hb3; (void)xn; (void)merged; (void)proj; (void)qc; (void)oc; (void)xs; (void)gates; (void)y2; (void)ya; (void)yb; (void)hmid; (void)h1b; (void)h2b; (void)ws

    if (IN(PH_PRO)) for (int rep_ = 0; rep_ < REPS(PH_PRO); ++rep_) { PHASE_IDS();
        LAS float* scr = (LAS float*)(lds + wave * 8704);
        const int gw = bx * 8 + wave, NGW = G * 8;
        constexpr int I0 = 16 * 72, I0C = 16 * 16, I1 = 16 * 64, I2 = 8 * 32, I4 = 16 * 32, I6 = 16 * 64, IE = 256;
        constexpr int NITEMS = I0 + I0C + I1 + 2 * I2 + 3 * I4 + I6 + 3 * 32 * IE;
        for (int it = gw; it < NITEMS; it += NGW) {
            int r = it;
            if (r < I0) { const int kb = r / 72, nb = r % 72; tr_item8(w_in, 2500, 2176, 32 * nb, 64 * kb, W8 + (size_t)(32 * nb) * 1024, 1024, 32.f, scr, lane); continue; } r -= I0;
            if (r < I0C) { const int kb = r / 16, nb = r % 16; tr_item(w_in, 2500, 2500, C_QI + 32 * nb, 64 * kb, Wi + (size_t)(32 * nb) * 1024, 1024, scr, lane); continue; } r -= I0C;
            if (r < I1) { const int kb = r / 64, nb = r % 64; tr_item8(w_gate, 2048, 2048, 32 * nb, 64 * kb, W8 + (size_t)(2304 + 32 * nb) * 1024, 1024, 32.f, scr, lane); continue; } r -= I1;
            if (r < I2) { const int kb = r / 32, nb = r % 32; tr_item8(w_branch_a, 1024, 1024, 32 * nb, 64 * kb, Wa + (size_t)(32 * nb) * 1024, 1024, 16.f, scr, lane); continue; } r -= I2;
            if (r < I2) { const int kb = r / 32, nb = r % 32; tr_item8(w_branch_b, 1024, 1024, 32 * nb, 64 * kb, Wa + 512 + (size_t)(32 * nb) * 1024, 1024, 16.f, scr, lane); continue; } r -= I2;
            if (r < I4) { const int kb = r / 32, nb = r % 32; tr_item8(w_out, 1024, 1024, 32 * nb, 64 * kb, Wout + (size_t)(32 * nb) * 1024, 1024, 32.f, scr, lane); continue; } r -= I4;
            if (r < I4) { const int kb = r / 32, nb = r % 32; tr_item8(w_cq, 1024, 1024, 32 * nb, 64 * kb, Wcq + (size_t)(32 * nb) * 1024, 1024, 32.f, scr, lane); continue; } r -= I4;
            if (r < I6) { const int kb = r / 64, nb = r % 64; tr_item8(w_ckv, 2048, 2048, 32 * nb, 64 * kb, Wckv + (size_t)(32 * nb) * 1024, 1024, 32.f, scr, lane); continue; } r -= I6;
            if (r < I4) { const int kb = r / 32, nb = r % 32; tr_item8(w_co, 1024, 1024, 32 * nb, 64 * kb, Wco + (size_t)(32 * nb) * 1024, 1024, 32.f, scr, lane); continue; } r -= I4;
            if (r < 32 * IE) { const int e = r / IE, q = r % IE, kb = q / 16, nb = q % 16, n0 = 32 * nb;
                tr_item8(w1 + (size_t)e * 1024 * 512, 512, 512, n0, 64 * kb, W13 + ((size_t)e * 1024 + 256 * (n0 >> 7) + (n0 & 127)) * 1024, 1024, 32.f, scr, lane); continue; } r -= 32 * IE;
            if (r < 32 * IE) { const int e = r / IE, q = r % IE, kb = q / 16, nb = q % 16, n0 = 32 * nb;
                tr_item8(w3 + (size_t)e * 1024 * 512, 512, 512, n0, 64 * kb, W13 + ((size_t)e * 1024 + 256 * (n0 >> 7) + 128 + (n0 & 127)) * 1024, 1024, 32.f, scr, lane); continue; } r -= 32 * IE;
            { const int e = r / IE, q = r % IE, kb = q / 32, nb = q % 32;
                tr_item8(w2 + (size_t)e * 512 * 1024, 1024, 1024, 32 * nb, 64 * kb, W2 + ((size_t)e * 1024 + 32 * nb) * 512, 512, 32.f, scr, lane); }
        }
        for (int m = 4 * gw; m < NTOK; m += 4 * NGW) rms_rows4_fp8<true>(x + (size_t)m * 1024, 1024, mix_norm, xn8 + (size_t)m * 1024, xn + (size_t)m * 1024, lane);
        for (int m = 4 * gw; m < NB * NMEM; m += 4 * NGW) rms_rows4_fp8<false>(mem + (size_t)m * 1024, 1024, mem_norm, memn8 + (size_t)m * 1024, (bf16_t*)nullptr, lane);
        for (int i = bx * 512 + tid; i < NTOK; i += G * 512) rowss[i] = 0.f;
        for (int i = bx * 512 + tid; i < 36 * 1024; i += G * 512) { const int j = i >> 10, k = i & 1023;
            const float w = ffn_norm[k] * (j < 32 ? w_router[k * 32 + j] : w_group[k * 4 + (j - 32)]);
            const unsigned hb = cvt_pk_bf16(w, 0.f) & 0xffffu; const float wl = w - bf_lo(hb);
            wrh[i] = (bf16_t)hb; wrh[36 * 1024 + i] = (bf16_t)(cvt_pk_bf16(wl, 0.f) & 0xffffu); }
    }
    SEAM(PH_PRO);

    if (IN(PH_PROJ)) for (int rep_ = 0; rep_ < REPS(PH_PROJ); ++rep_) { PHASE_IDS();
        LAS float* bgl = (LAS float*)(lds + 131072);
        for (int i = tid; i < 2048; i += 512) bgl[i] = b_gate[i];
        { pg8::Gemm g{(const bf16_t*)xn8, (const bf16_t*)W8, 1024}; pg8::StaticOrder S; S.init(NTOK, 4352, 512, G, bx);
          pg8::EpiProj E{proj, gates, bgl, 0}; pg8::gemm_phase<false, true>(lds, g, S, E); }
        { pg8::Gemm g{xn, Wi, 1024}; pg8::StaticOrder S; S.init(NTOK, 512, 1024, G, bx);
          pg8::EpiProj E{proj, gates, bgl, 1}; pg8::gemm_phase(lds, g, S, E); }
    }
    SEAM(PH_PROJ);

    if (IN(PH_MIX)) { PHASE_IDS();
        float lam;
        { const float a = wave_sum(lam_q1[lane] * lam_k1[lane]), c = wave_sum(lam_q2[lane] * lam_k2[lane]); lam = __expf(a) - __expf(c) + 0.2f; }
        const int vcu = (G % 8 == 0) ? (bx % 8) * (G / 8) + bx / 8 : bx;
        if (tid < 128) ((LAS float*)(lds + 131072))[tid] = diff_subln[tid];
        for (int rep_ = 0; rep_ < REPS(100); ++rep_)
        for (int L = vcu; L < 2048; L += G) { const int i = L >> 8, c = L & 255, grp = c >> 4, k = c & 15, bh = grp * 8 + i;
            const int qb = (i & 1) ? (15 - k) : k;
            diffattn_unit(proj, ya, diff_subln, lam, bh >> 2, bh & 3, qb, lds, tid); }
        for (int rep_ = 0; rep_ < REPS(101); ++rep_)
        for (int L = vcu; L < 2048; L += G) { const int i = L >> 8, c = L & 255, grp = c >> 4, k = c & 15, b = grp * 2 + (i >> 2), ii = i & 3;
            const int qblk = (ii == 0) ? k : (ii == 1) ? (31 - k) : (ii == 2) ? (32 + k) : (63 - k);
            dsa_unit(proj, yb, b, qblk, lds, tid); }
    }
    SEAM(PH_MIX);

    if (IN(PH_BRANCH)) for (int rep_ = 0; rep_ < REPS(PH_BRANCH); ++rep_) { PHASE_IDS();
        pg8::Gemm g{(const bf16_t*)ya, (const bf16_t*)Wa, 1024}; pg8::StaticOrder S; S.init(NTOK, 1024, 512, G, bx); pg8::EpiBranchF E{gates, merged8}; pg8::gemm_phase<false, true>(lds, g, S, E);
    }
    SEAM(PH_BRANCH);

    if (IN(PH_OUT)) for (int rep_ = 0; rep_ < REPS(PH_OUT); ++rep_) { PHASE_IDS();
        { pg8::Gemm g{(const bf16_t*)merged8, (const bf16_t*)Wout, 1024}; pg8::StaticOrder S; S.init(NTOK, 1024, 512, G, bx); pg8::EpiResidSq E{x, h1b, xn2_8, cross_norm, rowss, 1.f / 256.f}; pg8::gemm_phase<false, true>(lds, g, S, E); }
        { pg8::Gemm g{(const bf16_t*)memn8, (const bf16_t*)Wckv, 1024}; pg8::StaticOrder S; S.init(NB * NMEM, 2048, 512, G, bx); pg8::EpiPlain E{kvc, 2048, 1.f / 32.f}; pg8::gemm_phase<false, true>(lds, g, S, E); }
    }
    SEAM(PH_OUT);

    if (IN(PH_CQ)) for (int rep_ = 0; rep_ < REPS(PH_CQ); ++rep_) { PHASE_IDS();
        pg8::Gemm g{(const bf16_t*)xn2_8, (const bf16_t*)Wcq, 1024}; pg8::StaticOrder S; S.init(NTOK, 1024, 512, G, bx); pg8::EpiRowScale E{qc, 1024, rowss, 1.f / 32.f}; pg8::gemm_phase<false, true>(lds, g, S, E);
    }
    SEAM(PH_CQ);

    if (IN(PH_CROSS)) for (int rep_ = 0; rep_ < REPS(PH_CROSS); ++rep_) { PHASE_IDS();
        const int vcu = (G % 8 == 0) ? (bx % 8) * (G / 8) + bx / 8 : bx;
        for (int L = vcu; L < 2048; L += G) { const int i = L >> 8, c = L & 255, bhx = (c >> 4) * 8 + i; cross_unit(qc, kvc, oc, bhx >> 2, bhx & 3, c & 15, lds, tid); }
    }
    SEAM(PH_CROSS);

    if (IN(PH_CO)) { PHASE_IDS();
        pg8::Gemm g{(const bf16_t*)oc, (const bf16_t*)Wco, 1024}; pg8::StaticOrder S; S.init(NTOK, 1024, 512, G, bx); pg8::EpiResidHb E{h1b, h2b, hb3, ffn_norm, 1.f / 512.f}; pg8::gemm_phase<false, true>(lds, g, S, E);
    }
    SEAM(PH_CO);

    if (IN(PH_ROUTE)) for (int rep_ = 0; rep_ < REPS(PH_ROUTE); ++rep_) { PHASE_IDS();
        for (int tb = bx; tb < 256; tb += G) router_block(h2b, wrh, lds, b_router, b_group, tb, tok_e, tok_g, tok_inv, hist, tab, tid);
    }
    SEAM(PH_ROUTE);

    if (IN(PH_SLOT)) for (int rep_ = 0; rep_ < REPS(PH_SLOT); ++rep_) { PHASE_IDS();
        for (int tb = bx; tb < 256; tb += G) {
            moe_tables(hist, tab, tb, tid);
            LAS int* wcnt = tab + 700;
            int E0 = 0, E1 = 0, r0 = 0, r1 = 0;
            if (tid < 256) {
                const int pe = tok_e[tb * 256 + tid]; E0 = pe & 255; E1 = pe >> 8;
                const unsigned long long lt = (1ull << lane) - 1ull;
                for (int e = 0; e < 32; ++e) { const unsigned long long mk = __ballot((E0 == e) || (E1 == e));
                    const int rk = __popcll(mk & lt);
                    if (E0 == e) r0 = rk; if (E1 == e) r1 = rk;
                    if (lane == 0) wcnt[wave * 32 + e] = __popcll(mk); }
            }
            __syncthreads();
            if (tid < 256) {
                int o0 = 0, o1 = 0;
                for (int w = 0; w < wave; ++w) { o0 += wcnt[w * 32 + E0]; o1 += wcnt[w * 32 + E1]; }
                const int s0 = tab[32 + E0] + tab[640 + E0] + o0 + r0, s1 = tab[32 + E1] + tab[640 + E1] + o1 + r1;
                const int tok = tb * 256 + tid;
                sdest[s0] = 2 * tok; sdest[s1] = 2 * tok + 1; sgate[s0] = tok_g[2 * tok]; sgate[s1] = tok_g[2 * tok + 1]; stok[s0] = tok; stok[s1] = tok; { const float iv = tok_inv[tok] * (1.f / 32.f); siv[s0] = iv; siv[s1] = iv; }
            }
            if (tb == 0) {
                for (int e = wave; e < 32; e += 8) { const int cnt = tab[e], st = tab[32 + e], pend = ((cnt + 255) >> 8) << 8;
                    for (int s = cnt + lane; s < pend; s += 64) { sdest[st + s] = -1; sgate[st + s] = 0.f; stok[st + s] = 0; siv[st + s] = 0.f; } }
            }
            __syncthreads();
        }
    }
    SEAM(PH_SLOT);

    if (IN(PH_UP)) for (int rep_ = 0; rep_ < REPS(PH_UP); ++rep_) { PHASE_IDS();
        moe_tables(hist, tab, 0, tid);
        pg8::Gemm g{(const bf16_t*)hb3, (const bf16_t*)W13, 1024};
        pg8::MoeOrder S; S.G = G; S.c = bx; S.n_units = tab[108] * 4; S.rb2e = (const LAS unsigned char*)(tab + 1600); S.ridx = stok;
        S.a_step = 0; S.b_estep = (size_t)1024 * 1024; S.b_tstep = (size_t)256 * 1024;
        pg8::EpiSwiGLU E{hmid, sgate, siv};
        pg8::gemm_phase<true, true>(lds, g, S, E);
    }
    SEAM(PH_UP);

    if (IN(PH_DOWN)) for (int rep_ = 0; rep_ < REPS(PH_DOWN); ++rep_) { PHASE_IDS();
        moe_tables(hist, tab, 0, tid);
        pg8::Gemm g{(const bf16_t*)hmid, (const bf16_t*)W2, 512};
        pg8::MoeOrder S; S.G = G; S.c = bx; S.n_units = tab[108] * 4; S.rb2e = (const LAS unsigned char*)(tab + 1600);
        S.a_step = (size_t)256 * 512; S.b_estep = (size_t)1024 * 512; S.b_tstep = (size_t)256 * 512; S.ridx = nullptr;
        pg8::EpiDown E{y2, sdest};
        pg8::gemm_phase<false, true>(lds, g, S, E);
    }
    SEAM(PH_DOWN);

    if (IN(PH_FINAL)) { PHASE_IDS();
        const int gw = bx * 8 + wave, NGW = G * 8;
        for (int m = gw; m < NTOK; m += NGW) {
            f32x4* xr = (f32x4*)(out + (size_t)m * 1024) + lane; const f32x4* gr = (const f32x4*)final_norm + lane; const u32x2* hr = (const u32x2*)(h2b + (size_t)m * 1024) + lane;
            const unsigned* ya_ = (const unsigned*)(y2 + (size_t)(2 * m) * 1024) + lane; const unsigned* yb_ = (const unsigned*)(y2 + (size_t)(2 * m + 1) * 1024) + lane;
            f32x4 v[4]; float s = 0.f;
#pragma unroll
            for (int j = 0; j < 4; ++j) { const u32x2 hw = hr[64 * j]; v[j] = (f32x4){bf_lo(hw.x), bf_hi(hw.x), bf_lo(hw.y), bf_hi(hw.y)}; const int a = (int)ya_[64 * j], c = (int)yb_[64 * j];
                const f32x2 a0 = __builtin_amdgcn_cvt_pk_f32_fp8(a, false), a1 = __builtin_amdgcn_cvt_pk_f32_fp8(a, true), c0 = __builtin_amdgcn_cvt_pk_f32_fp8(c, false), c1 = __builtin_amdgcn_cvt_pk_f32_fp8(c, true);
                v[j].x += (a0.x + c0.x) * (1.f / 16.f); v[j].y += (a0.y + c0.y) * (1.f / 16.f); v[j].z += (a1.x + c1.x) * (1.f / 16.f); v[j].w += (a1.y + c1.y) * (1.f / 16.f);
                s += (v[j].x * v[j].x + v[j].y * v[j].y) + (v[j].z * v[j].z + v[j].w * v[j].w); }
            const float r = rsqrtf(wave_sum(s) * (1.f / 1024.f) + EPS);
#pragma unroll
            for (int j = 0; j < 4; ++j) { const f32x4 gv = gr[64 * j]; xr[64 * j] = (f32x4){v[j].x * r * gv.x, v[j].y * r * gv.y, v[j].z * r * gv.z, v[j].w * r * gv.w}; }
        }
    }
#undef IN
#undef SEAM
}

extern "C" void kernel_launch(void* const* d_in, const int* in_sizes, int n_in, void* d_out, int out_size, void* d_ws, size_t ws_size, hipStream_t stream) {
    static int grid = 0;
    if (grid == 0) {
        if (n_in != 28 || out_size != NTOK * DM || ws_size < WS_END) { fprintf(stderr, "kernel_launch: unexpected shapes (n_in %d out %d ws %zu)\n", n_in, out_size, ws_size); grid = -1; return; }
        int dev = 0, cus = 0, per_cu = 0;
        if (hipGetDevice(&dev) != hipSuccess || hipDeviceGetAttribute(&cus, hipDeviceAttributeMultiprocessorCount, dev) != hipSuccess) { grid = -1; return; }
        if (hipFuncSetAttribute((const void*)fwd_kernel, hipFuncAttributeMaxDynamicSharedMemorySize, LDS_BYTES) != hipSuccess) { fprintf(stderr, "kernel_launch: hipFuncSetAttribute failed\n"); grid = -1; return; }
        if (hipOccupancyMaxActiveBlocksPerMultiprocessor(&per_cu, (const void*)fwd_kernel, 512, LDS_BYTES) != hipSuccess || per_cu < 1) { fprintf(stderr, "kernel_launch: occupancy query says %d\n", per_cu); }
        (void)hipGetLastError();
        grid = cus;
    }
    if (grid < 0) return;
    hipMemsetAsync((char*)d_ws + WS_CTL, 0, CTL_ZERO_BYTES, stream);
    Args a{};
    for (int i = 0; i < 28; ++i) a.in[i] = (const float*)d_in[i];
    a.out = (float*)d_out; a.ws = (unsigned char*)d_ws;
#if N_LAUNCH_SPLIT
    for (int p = 0; p < N_PHASES; ++p) { a.ph_lo = p; a.ph_hi = p + 1; hipLaunchKernelGGL(fwd_kernel, dim3(grid), dim3(512), LDS_BYTES, stream, a); }
#else
    a.ph_lo = 0; a.ph_hi = N_PHASES; hipLaunchKernelGGL(fwd_kernel, dim3(grid), dim3(512), LDS_BYTES, stream, a);
#endif
}
```

```cpp
#include <hip/hip_runtime.h>
#include <cstdio>
#include <cstdint>

#ifndef N_LAUNCH_SPLIT
#define N_LAUNCH_SPLIT 0
#endif

#ifndef REP_PHASE
#define REP_PHASE (-1)
#endif
#define REPS(k) ((REP_PHASE == (k)) ? 2 : 1)
#define LAS __attribute__((address_space(3)))
#define GAS __attribute__((address_space(1)))
typedef unsigned short bf16_t;
typedef short bf16x8 __attribute__((ext_vector_type(8)));
typedef short s16x4 __attribute__((ext_vector_type(4)));
typedef float f32x2 __attribute__((ext_vector_type(2)));
typedef float f32x4 __attribute__((ext_vector_type(4)));
typedef float f32x16 __attribute__((ext_vector_type(16)));
typedef unsigned u32x2 __attribute__((ext_vector_type(2)));
typedef unsigned u32x4 __attribute__((ext_vector_type(4)));
typedef __bf16 bf16x2_t __attribute__((ext_vector_type(2)));
typedef int v4i32 __attribute__((ext_vector_type(4)));
typedef int v8i32 __attribute__((ext_vector_type(8)));

constexpr int NB = 32, SEQ = 2048, DM = 1024, NTOK = NB * SEQ, NMEM = 256;
constexpr int PW = 2560;
constexpr int C_QA = 0, C_KA = 512, C_VA = 1024, C_QB = 1536, C_KB = 2048, C_VB = 2112, C_QI = 2176, C_KI = 2432, C_WI = 2496;
constexpr int NEXP = 32, DEXP = 512;
constexpr int MAXSLOT = 2 * NTOK + NEXP * 256;
constexpr float EPS = 1e-6f, LOG2E = 1.4426950408889634f;

constexpr size_t MiB = 1u << 20;
constexpr size_t WS_CTL = 0, CTL_ZERO_BYTES = 64 * 1024;
constexpr size_t WS_ROWSS = 512 * 1024;
constexpr size_t WS_TOKE = 1 * MiB;
constexpr size_t WS_TOKG = WS_TOKE + 256 * 1024;
constexpr size_t WS_TOKINV = WS_TOKG + 512 * 1024;
constexpr size_t WS_HIST = 2 * MiB;
constexpr size_t WS_WRT  = WS_HIST + 32 * 1024;
constexpr size_t WS_SDEST = 2 * MiB + 256 * 1024;
constexpr size_t WS_STOK  = WS_SDEST + 576 * 1024;
constexpr size_t WS_SGATE = WS_STOK + 576 * 1024;
static_assert(WS_WRT + 36 * 1024 * 4 <= WS_SDEST && WS_SGATE + (size_t)MAXSLOT * 4 <= 4 * MiB && (size_t)MAXSLOT * 4 <= 576 * 1024, "small arrays");
constexpr size_t WS_WCAT = 4 * MiB;
constexpr size_t WS_WA = 13 * MiB, WS_WB = 14 * MiB, WS_WOUT = 15 * MiB, WS_WCQ = 17 * MiB, WS_WCKV = 19 * MiB, WS_WCO = 23 * MiB;
constexpr size_t WS_W13 = 25 * MiB;
constexpr size_t WS_W2 = 89 * MiB;
constexpr size_t WS_MEMN = 121 * MiB;
constexpr size_t WS_KVC = 137 * MiB;
constexpr size_t WS_R1 = 176 * MiB;
constexpr size_t WS_R2 = 304 * MiB;
constexpr size_t WS_R3 = 624 * MiB;
constexpr size_t WS_R4 = 880 * MiB;
constexpr size_t WS_SIV = 1016 * MiB;
constexpr size_t WS_END = 1017 * MiB;
static_assert(WS_R4 + (size_t)MAXSLOT * DEXP * 2 <= WS_SIV && WS_SIV + (size_t)MAXSLOT * 4 <= WS_END, "ws map");
static_assert(WS_R2 + (size_t)MAXSLOT * DM * 2 <= WS_R3, "ws map");
constexpr int CW_BAR = 1024;

constexpr int SCR_BYTES = 135424;
constexpr int ISC_PITCH = 4232;
constexpr int MASK_OFF = SCR_BYTES, MASK_PITCH_W = 66;
constexpr int TAB_OFF = MASK_OFF + 32 * MASK_PITCH_W * 4;
constexpr int TAB_BYTES = 8192;
constexpr int QIDX_OFF = TAB_OFF;
constexpr int MISC_OFF = 163840 - 256;
constexpr int LDS_BYTES = MISC_OFF + 256;
static_assert(TAB_OFF % 16 == 0 && MISC_OFF % 16 == 0 && LDS_BYTES <= 163840 && TAB_OFF + TAB_BYTES <= MISC_OFF && QIDX_OFF + 32 * 528 <= MISC_OFF, "lds map");

__device__ __forceinline__ unsigned cvt_pk_bf16(float lo, float hi) { f32x2 v = {lo, hi}; bf16x2_t b = __builtin_convertvector(v, bf16x2_t); return __builtin_bit_cast(unsigned, b); }
__device__ __forceinline__ unsigned pack4_fp8(float a, float b, float c, float d) { int w = 0; w = __builtin_amdgcn_cvt_pk_fp8_f32(a, b, w, false); w = __builtin_amdgcn_cvt_pk_fp8_f32(c, d, w, true); return (unsigned)w; }
__device__ __forceinline__ float bf_lo(unsigned w) { return __uint_as_float(w << 16); }
__device__ __forceinline__ float bf_hi(unsigned w) { return __uint_as_float(w & 0xffff0000u); }
__device__ __forceinline__ float bf2f(bf16_t b) { return __uint_as_float((unsigned)b << 16); }
__device__ __forceinline__ float wave_sum(float v) {
#pragma unroll
    for (int o = 1; o < 64; o <<= 1) v += __shfl_xor(v, o);
    return v;
}
__device__ __forceinline__ float xor32_sum(float v) {
    const auto rr = __builtin_amdgcn_permlane32_swap(__float_as_uint(v), __float_as_uint(v), false, false);
    return __uint_as_float(rr[0]) + __uint_as_float(rr[1]);
}
__device__ __forceinline__ float fexp2(float x) { return __builtin_amdgcn_exp2f(x); }
__device__ __forceinline__ float frcp(float x) { return __builtin_amdgcn_rcpf(x); }
__device__ __forceinline__ int crow(int r, int hi) { return (r & 3) + 8 * (r >> 2) + 4 * hi; }
#define LDS_WAIT() asm volatile("s_waitcnt lgkmcnt(0)" ::: "memory")
#define VM_WAIT() asm volatile("s_waitcnt vmcnt(0)" ::: "memory")

namespace pg8 {
constexpr int BM = 256, BK = 64, HALF = 128, HTB = HALF * BK * 2, NXCD = 8, WGM = 8;
__host__ __device__ __forceinline__ int lds_byte(int r, int c) { const int st = (r >> 4) * 2 + (c >> 5), rr = r & 15, cc = c & 31, ob = rr * 64 + cc * 2; return st * 1024 + (ob ^ (((ob >> 9) & 1) << 5)); }
__host__ __device__ __forceinline__ void stage_rc(int b, int& R, int& C) { const int st = b / 1024, sb = b % 1024, swz = sb ^ (((sb >> 9) & 1) << 5); R = (st >> 1) * 16 + swz / 64; C = (st & 1) * 32 + (swz % 64) / 2; }
__host__ __device__ __forceinline__ int perm32(int rho) { const int n = rho >> 4, i = rho & 15; return 8 * (i >> 2) + 4 * n + (i & 3); }

struct Unit { int pm, pn, e; };
struct Gemm { const bf16_t* A; const bf16_t* Bt; int K; };

struct StaticOrder {
    int nM, nN, nwg, G, c; size_t tstep;
    __device__ void init(int M, int N, int K, int G_, int c_) { nM = M / BM; nN = N / BM; nwg = nM * nN; G = G_; c = c_; tstep = (size_t)BM * K * 2; }
    __device__ __forceinline__ bool next(int i, Unit& u) const {
        const long L = (long)i * G + c; if (L >= nwg) return false;
        int wgid = (int)L; { const int q = nwg / NXCD, r = nwg % NXCD, xcd = wgid % NXCD, off = wgid / NXCD; wgid = (xcd < r ? xcd * (q + 1) : r * (q + 1) + (xcd - r) * q) + off; }
        const int nig = WGM * nN, gid = wgid / nig, fm = gid * WGM, gsz = (nM - fm) < WGM ? (nM - fm) : WGM;
        u.pm = fm + ((wgid % nig) % gsz); u.pn = (wgid % nig) / gsz; u.e = 0; return true;
    }
    __device__ __forceinline__ const char* pa(const Gemm& g, const Unit& u) const { return (const char*)g.A + (size_t)u.pm * tstep; }
    __device__ __forceinline__ const char* pb(const Gemm& g, const Unit& u) const { return (const char*)g.Bt + (size_t)u.pn * tstep; }
    __device__ __forceinline__ const int* rowidx() const { return nullptr; }
};
struct MoeOrder {
    int G, c, n_units; const LAS unsigned char* rb2e; size_t a_step, b_estep, b_tstep; const int* ridx;
    __device__ __forceinline__ const int* rowidx() const { return ridx; }
    __device__ __forceinline__ bool next(int i, Unit& u) const {
        const int L = i * G + c; if (L >= n_units) return false;
        u.pm = L >> 2; u.pn = L & 3; u.e = rb2e[u.pm]; return true;
    }
    __device__ __forceinline__ const char* pa(const Gemm& g, const Unit& u) const { return (const char*)g.A + (size_t)u.pm * a_step; }
    __device__ __forceinline__ const char* pb(const Gemm& g, const Unit& u) const { return (const char*)g.Bt + (size_t)u.e * b_estep + (size_t)u.pn * b_tstep; }
};

template <bool F8> struct FragT;
template <class E> struct EpiBadj { static constexpr bool v = false; };
template <class E> struct EpiMid { static constexpr bool v = false; };
template <> struct FragT<false> {
    struct Fr { bf16x8 k[2]; }; struct A4 { Fr f[4]; }; struct B2 { Fr f[2]; };
    static __device__ __forceinline__ void load(Fr& d, const LAS unsigned char* p) { d.k[0] = *(const LAS bf16x8*)p; d.k[1] = *(const LAS bf16x8*)(p + 1024); }
    static __device__ __forceinline__ void mma(f32x4& c, const Fr& b, const Fr& a) { c = __builtin_amdgcn_mfma_f32_16x16x32_bf16(b.k[0], a.k[0], c, 0, 0, 0); c = __builtin_amdgcn_mfma_f32_16x16x32_bf16(b.k[1], a.k[1], c, 0, 0, 0); }
};
template <> struct FragT<true> {
    struct Fr { v8i32 v; }; struct A4 { Fr f[4]; }; struct B2 { Fr f[2]; };
    static __device__ __forceinline__ void load(Fr& d, const LAS unsigned char* p) { const v4i32 lo = *(const LAS v4i32*)p, hi = *(const LAS v4i32*)(p + 1024); d.v = __builtin_shufflevector(lo, hi, 0, 1, 2, 3, 4, 5, 6, 7); }
    static __device__ __forceinline__ void mma(f32x4& c, const Fr& b, const Fr& a) {
        asm volatile("v_mfma_scale_f32_16x16x128_f8f6f4 %0, %1, %2, %0, %3, %3 op_sel_hi:[0,0,0]" : "+v"(c) : "v"(b.v), "v"(a.v), "v"(0x7f7f7f7f)); }
};
template <bool GATHER = false, bool F8 = false, class Epi, class Sched>
__device__ __forceinline__ void gemm_phase(LAS unsigned char* lds, const Gemm g, const Sched& S, const Epi& E) {
    const int tid = threadIdx.x, wid = __builtin_amdgcn_readfirstlane(tid >> 6), lane = tid & 63, wr = wid >> 2, wc = wid & 3, fr = lane & 15, fq = lane >> 4;
    const int K = F8 ? g.K / 2 : g.K, nt = K / BK;
    unsigned voffB[2]; int RA[2], CA2[2];
    unsigned vA0c[2], vA1c[2], vA0n[2], vA1n[2];
    const size_t kstep = (size_t)(BK * 2);
    const size_t hstep = (size_t)HALF * K * 2;
    constexpr bool BADJ = EpiBadj<Epi>::v;
    const size_t hstepB = BADJ ? (size_t)8 * K * 2 : hstep;
#pragma unroll
    for (int i = 0; i < 2; ++i) { int R, C; stage_rc(tid * 16 + i * 8192, R, C); const int Rb = BADJ ? 64 * (R >> 5) + 16 * ((R & 15) >> 2) + 4 * ((R & 31) >> 4) + (R & 3) : (R & ~31) + perm32(R & 31);
        RA[i] = R; CA2[i] = C * 2; voffB[i] = (unsigned)(Rb * K + C) * 2u;
        vA0c[i] = (unsigned)(R * K + C) * 2u; vA1c[i] = vA0c[i] + (unsigned)hstep; vA0n[i] = vA0c[i]; vA1n[i] = vA1c[i]; }
#define PG8_ROWS(v0, v1, u) do { if (GATHER) { const int* ri_ = S.rowidx() + (size_t)(u).pm * BM; _Pragma("unroll") for (int i_ = 0; i_ < 2; ++i_) { \
        v0[i_] = (unsigned)ri_[RA[i_]] * (unsigned)(K * 2) + (unsigned)CA2[i_]; v1[i_] = (unsigned)ri_[HALF + RA[i_]] * (unsigned)(K * 2) + (unsigned)CA2[i_]; } \
        _Pragma("unroll") for (int i_ = 0; i_ < 2; ++i_) { asm volatile("" : "+v"(v0[i_])); asm volatile("" : "+v"(v1[i_])); } } } while (0)
#define PG8_SEL(n, c) (GATHER ? (last ? (n) : (c)) : (c))
    const unsigned ldsw = (unsigned)wid * 1024u;
    const int aoff = lds_byte(wr * 64 + fr, fq * 8), boff = lds_byte(wc * 32 + fr, fq * 8);
#define PG8_SA(b, h) (((b) * 2 + (h)) * HTB)
#define PG8_SB(b, h) ((4 + (b) * 2 + (h)) * HTB)
#define PG8_STAGE(bufoff, gbase, voff) do { _Pragma("unroll") for (int _i = 0; _i < 2; ++_i) \
        __builtin_amdgcn_global_load_lds((const unsigned*)((const char*)(gbase) + (voff)[_i]), (LAS unsigned*)(lds + (bufoff) + ldsw + _i * 8192), 16, 0, 0); } while (0)
#define PG8_LDA(dst, b, h) do { _Pragma("unroll") for (int m = 0; m < 4; ++m) FragT<F8>::load(dst.f[m], lds + PG8_SA(b, h) + aoff + m * 2048); } while (0)
#define PG8_LDB(dst, b, h) do { _Pragma("unroll") for (int n = 0; n < 2; ++n) FragT<F8>::load(dst.f[n], lds + PG8_SB(b, h) + boff + n * 2048); } while (0)
#define PG8_MMA(ai, bj, At, Bt) do { if constexpr (F8) __builtin_amdgcn_sched_barrier(0); __builtin_amdgcn_s_setprio(1); _Pragma("unroll") for (int m = 0; m < 4; ++m) _Pragma("unroll") for (int n = 0; n < 2; ++n) \
        FragT<F8>::mma(acc[ai][bj][m][n], Bt.f[n], At.f[m]); __builtin_amdgcn_s_setprio(0); if constexpr (F8) __builtin_amdgcn_sched_barrier(0); } while (0)
#define PG8_WAIT_V(n) asm volatile("s_waitcnt vmcnt(" #n ")" ::: "memory")
#define PG8_WAIT_L(n) asm volatile("s_waitcnt lgkmcnt(" #n ")" ::: "memory")
#define PG8_BAR __builtin_amdgcn_s_barrier()
#define PG8_SCHED __builtin_amdgcn_sched_barrier(0)
    Unit cur, nxt; int ui = 0;
    if (!S.next(0, cur)) return;
    f32x4 acc[2][2][4][2];
#pragma unroll
    for (int a = 0; a < 2; ++a)
#pragma unroll
        for (int b = 0; b < 2; ++b)
#pragma unroll
            for (int m = 0; m < 4; ++m)
#pragma unroll
                for (int n = 0; n < 2; ++n) acc[a][b][m][n] = (f32x4){0.f, 0.f, 0.f, 0.f};
    typedef typename FragT<F8>::A4 AFr; typedef typename FragT<F8>::B2 BFr;
    AFr At; BFr B0, B1;
    const char* cA = S.pa(g, cur); const char* cB = S.pb(g, cur);
    PG8_ROWS(vA0c, vA1c, cur);
    PG8_STAGE(PG8_SB(0, 0), cB, voffB); PG8_STAGE(PG8_SB(0, 1), cB + hstepB, voffB); PG8_STAGE(PG8_SA(0, 0), cA, vA0c); PG8_STAGE(PG8_SA(0, 1), cA, vA1c);
    if (wr == 1) PG8_BAR;
    PG8_WAIT_V(2); PG8_BAR;
    PG8_STAGE(PG8_SB(1, 0), cB + kstep, voffB); PG8_STAGE(PG8_SA(1, 0), cA + kstep, vA0c); PG8_STAGE(PG8_SB(1, 1), cB + hstepB + kstep, voffB);
    PG8_WAIT_V(6); PG8_BAR;
    for (;;) {
        const bool has_next = S.next(ui + 1, nxt);
        const char* nA = has_next ? S.pa(g, nxt) : cA; const char* nB = has_next ? S.pb(g, nxt) : cB;
        if (GATHER) { if (has_next) PG8_ROWS(vA0n, vA1n, nxt); else {
#pragma unroll
            for (int i = 0; i < 2; ++i) { vA0n[i] = vA0c[i]; vA1n[i] = vA1c[i]; } } }
#pragma unroll 1
        for (int t = 0; t < nt; t += 2) {
            const bool last = (t == nt - 2);
            const char* a1 = cA + (size_t)(t + 1) * kstep;
            const char* a2 = last ? nA : cA + (size_t)(t + 2) * kstep; const char* b2 = last ? nB : cB + (size_t)(t + 2) * kstep;
            const char* a3 = a2 + kstep; const char* b3 = b2 + kstep;
            unsigned w0[2], w1[2];
#pragma unroll
            for (int i = 0; i < 2; ++i) { w0[i] = PG8_SEL(vA0n[i], vA0c[i]); w1[i] = PG8_SEL(vA1n[i], vA1c[i]); }
            PG8_LDB(B0, 0, 0); PG8_LDB(B1, 0, 1); PG8_SCHED; PG8_LDA(At, 0, 0); PG8_STAGE(PG8_SA(1, 1), a1, vA1c);
            PG8_WAIT_V(8); PG8_WAIT_L(0); PG8_BAR; PG8_MMA(0, 0, At, B0); PG8_MMA(0, 1, At, B1); PG8_BAR; PG8_SCHED;
            PG8_LDA(At, 0, 1); PG8_STAGE(PG8_SB(0, 0), b2, voffB); PG8_STAGE(PG8_SB(0, 1), b2 + hstepB, voffB); PG8_STAGE(PG8_SA(0, 0), a2, w0);
            PG8_WAIT_V(8); PG8_WAIT_L(0); PG8_BAR; PG8_MMA(1, 0, At, B0); PG8_MMA(1, 1, At, B1); PG8_BAR; PG8_SCHED;
            PG8_LDB(B0, 1, 0); PG8_LDB(B1, 1, 1); PG8_SCHED; PG8_LDA(At, 1, 0); PG8_STAGE(PG8_SA(0, 1), a2, w1);
            PG8_WAIT_V(8); PG8_WAIT_L(0); PG8_BAR; PG8_MMA(0, 0, At, B0); PG8_MMA(0, 1, At, B1); PG8_BAR; PG8_SCHED;
            PG8_LDA(At, 1, 1); PG8_STAGE(PG8_SB(1, 0), b3, voffB); PG8_STAGE(PG8_SB(1, 1), b3 + hstepB, voffB); PG8_STAGE(PG8_SA(1, 0), a3, w0);
            PG8_WAIT_V(8); PG8_WAIT_L(0); PG8_BAR; PG8_MMA(1, 0, At, B0); PG8_MMA(1, 1, At, B1); PG8_BAR; PG8_SCHED;
            if constexpr (EpiMid<Epi>::v) { if (t == nt / 2 - 2) {
                if constexpr (F8) asm volatile("s_nop 15\n\ts_nop 15" ::: "memory");
                E.mid(acc, cur, wr, wc, fr, fq);
                if constexpr (F8) asm volatile("s_nop 7" ::: "memory"); PG8_SCHED; } }
        }
        if (wr == 0) PG8_BAR;
        if constexpr (F8) asm volatile("s_nop 15\n\ts_nop 15" ::: "memory");
        E(acc, cur, wr, wc, fr, fq);
        if (!has_next) break;
#pragma unroll
        for (int a = 0; a < 2; ++a)
#pragma unroll
            for (int b = 0; b < 2; ++b)
#pragma unroll
                for (int m = 0; m < 4; ++m)
#pragma unroll
                    for (int n = 0; n < 2; ++n) acc[a][b][m][n] = (f32x4){0.f, 0.f, 0.f, 0.f};
        cur = nxt; cA = nA; cB = nB; ++ui;
#pragma unroll
        for (int i = 0; i < 2; ++i) { vA0c[i] = vA0n[i]; vA1c[i] = vA1n[i]; }
        if (wr == 1) PG8_BAR;
    }
    PG8_WAIT_V(0);
    PG8_BAR;
#undef PG8_ROWS
#undef PG8_SEL
#undef PG8_SA
#undef PG8_SB
#undef PG8_STAGE
#undef PG8_LDA
#undef PG8_LDB
#undef PG8_MMA
#undef PG8_WAIT_V
#undef PG8_WAIT_L
#undef PG8_BAR
#undef PG8_SCHED
}

typedef f32x4 AccT[2][2][4][2];
__device__ __forceinline__ u32x4 pack8(const f32x4& v0, const f32x4& v1) { u32x4 w; w.x = cvt_pk_bf16(v0[0], v0[1]); w.y = cvt_pk_bf16(v0[2], v0[3]); w.z = cvt_pk_bf16(v1[0], v1[1]); w.w = cvt_pk_bf16(v1[2], v1[3]); return w; }
__device__ __forceinline__ void unpack8(const u32x4& w, f32x4& v0, f32x4& v1) { v0 = (f32x4){bf_lo(w.x), bf_hi(w.x), bf_lo(w.y), bf_hi(w.y)}; v1 = (f32x4){bf_lo(w.z), bf_hi(w.z), bf_lo(w.w), bf_hi(w.w)}; }
__device__ __forceinline__ float sigmoidf_(float v) { return frcp(1.f + fexp2(-v * LOG2E)); }
__device__ __forceinline__ unsigned pack4_u8(const f32x4& v) { unsigned w = 0u; w = __builtin_amdgcn_cvt_pk_u8_f32(v[0], 0u, w); w = __builtin_amdgcn_cvt_pk_u8_f32(v[1], 1u, w); w = __builtin_amdgcn_cvt_pk_u8_f32(v[2], 2u, w); w = __builtin_amdgcn_cvt_pk_u8_f32(v[3], 3u, w); return w; }
__device__ __forceinline__ f32x4 unpack4_u8(unsigned w) { return (f32x4){(float)(w & 0xffu), (float)((w >> 8) & 0xffu), (float)((w >> 16) & 0xffu), (float)(w >> 24)}; }

struct EpiProj {
    bf16_t* proj; unsigned char* gates; const LAS float* bgate; int mode;
    __device__ __forceinline__ void operator()(const AccT& acc, const Unit& u, int wr, int wc, int fr, int fq) const {
        const int row0 = u.pm * BM + wr * 64 + fr;
        if (mode == 1 || u.pn < 9) {
            const int col0 = (mode == 1 ? C_QI : 0) + u.pn * BM + wc * 32 + 8 * fq; const float sc = (mode == 1) ? 1.f : (1.f / 32.f);
            const int nbj = ((mode == 1 && u.pn == 1) || (mode == 0 && u.pn == 8)) ? 1 : 2;
#pragma unroll
            for (int ai = 0; ai < 2; ++ai)
#pragma unroll
                for (int m = 0; m < 4; ++m) { bf16_t* rowp = proj + (size_t)(row0 + ai * HALF + m * 16) * PW + col0;
#pragma unroll
                    for (int bj = 0; bj < 2; ++bj) if (bj < nbj) *(u32x4*)(rowp + bj * HALF) = pack8(acc[ai][bj][m][0] * sc, acc[ai][bj][m][1] * sc); }
        } else {
            const int col0 = (u.pn - 9) * BM + wc * 32 + 8 * fq;
            f32x4 bv[2][2];
#pragma unroll
            for (int bj = 0; bj < 2; ++bj)
#pragma unroll
                for (int n = 0; n < 2; ++n) bv[bj][n] = *(const LAS f32x4*)(bgate + col0 + bj * HALF + 4 * n);
#pragma unroll
            for (int ai = 0; ai < 2; ++ai)
#pragma unroll
                for (int m = 0; m < 4; ++m) { unsigned char* rowp = gates + (size_t)(row0 + ai * HALF + m * 16) * 2048 + col0;
#pragma unroll
                    for (int bj = 0; bj < 2; ++bj) { f32x4 v0 = acc[ai][bj][m][0] * (1.f / 32.f) + bv[bj][0], v1 = acc[ai][bj][m][1] * (1.f / 32.f) + bv[bj][1];
#pragma unroll
                        for (int j = 0; j < 4; ++j) { v0[j] = sigmoidf_(v0[j]) * 255.f; v1[j] = sigmoidf_(v1[j]) * 255.f; }
                        u32x2 w; w.x = pack4_u8(v0); w.y = pack4_u8(v1); *(u32x2*)(rowp + bj * HALF) = w; } }
        }
    }
};
template <bool SECOND> struct EpiBranch {
    const unsigned char* gates; bf16_t* merged; unsigned char* merged8; float sc;
    __device__ __forceinline__ void operator()(const AccT& acc, const Unit& u, int wr, int wc, int fr, int fq) const {
        const int row0 = u.pm * BM + wr * 64 + fr, col0 = u.pn * BM + wc * 32 + 8 * fq;
#pragma unroll
        for (int ai = 0; ai < 2; ++ai)
#pragma unroll
            for (int m = 0; m < 4; ++m) { const size_t row = (size_t)(row0 + ai * HALF + m * 16);
#pragma unroll
                for (int bj = 0; bj < 2; ++bj) { const int col = col0 + bj * HALF;
                    const u32x2 gw = *(const u32x2*)(gates + row * 2048 + (SECOND ? 1024 : 0) + col);
                    const f32x4 g0 = unpack4_u8(gw.x), g1 = unpack4_u8(gw.y);
                    f32x4 v0 = g0 * acc[ai][bj][m][0] * sc, v1 = g1 * acc[ai][bj][m][1] * sc;
                    if (SECOND) { const u32x4 pw = *(const u32x4*)(merged + row * 1024 + col); f32x4 p0, p1; unpack8(pw, p0, p1); v0 = (v0 + p0) * 8.f; v1 = (v1 + p1) * 8.f;
                        u32x2 w; w.x = pack4_fp8(v0[0], v0[1], v0[2], v0[3]); w.y = pack4_fp8(v1[0], v1[1], v1[2], v1[3]); *(u32x2*)(merged8 + row * 1024 + col) = w; }
                    else *(u32x4*)(merged + row * 1024 + col) = pack8(v0, v1); } }
    }
};
struct EpiBranchF {
    const unsigned char* gates; unsigned char* merged8;
    __device__ __forceinline__ void mid(AccT& acc, const Unit& u, int wr, int wc, int fr, int fq) const {
        unsigned gbase = (unsigned)(u.pm * BM + wr * 64 + fr) * 2048u + (unsigned)(u.pn * BM + wc * 64 + 16 * fq); asm volatile("" : "+v"(gbase));
#pragma unroll
        for (int ai = 0; ai < 2; ++ai) { asm volatile("" ::: "memory");
#pragma unroll
            for (int m = 0; m < 4; ++m) { const unsigned go = gbase + (unsigned)(ai * HALF + m * 16) * 2048u;
                const u32x4 ga = *(const u32x4*)(gates + go), gb = *(const u32x4*)(gates + (go + 1024));
#pragma unroll
                for (int bj = 0; bj < 2; ++bj) {
                    const f32x4 a0 = unpack4_u8(ga[2 * bj]), a1 = unpack4_u8(ga[2 * bj + 1]), b0 = unpack4_u8(gb[2 * bj]), b1 = unpack4_u8(gb[2 * bj + 1]);
#pragma unroll
                    for (int j = 0; j < 4; ++j) { acc[ai][bj][m][0][j] *= 2.f * a0[j] * frcp(fmaxf(b0[j], 1.f)); acc[ai][bj][m][1][j] *= 2.f * a1[j] * frcp(fmaxf(b1[j], 1.f)); } } } }
    }
    __device__ __forceinline__ void operator()(const AccT& acc, const Unit& u, int wr, int wc, int fr, int fq) const {
        unsigned rbase = (unsigned)(u.pm * BM + wr * 64 + fr) * 1024u + (unsigned)(u.pn * BM + wc * 64 + 16 * fq); asm volatile("" : "+v"(rbase));
        const unsigned cpart = rbase & 1023u, gbase = 2u * (rbase - cpart) + cpart;
#pragma unroll
        for (int ai = 0; ai < 2; ++ai)
#pragma unroll
            for (int m = 0; m < 4; ++m) { const unsigned go = gbase + (unsigned)(ai * HALF + m * 16) * 2048u, ro = rbase + (unsigned)(ai * HALF + m * 16) * 1024u;
                const u32x4 gb = *(const u32x4*)(gates + (go + 1024)); u32x4 w;
#pragma unroll
                for (int bj = 0; bj < 2; ++bj) {
                    const f32x4 b0 = unpack4_u8(gb[2 * bj]), b1 = unpack4_u8(gb[2 * bj + 1]);
                    f32x4 v0, v1;
#pragma unroll
                    for (int j = 0; j < 4; ++j) { v0[j] = acc[ai][bj][m][0][j] * fmaxf(b0[j], 1.f) * (1.f / (16.f * 255.f)); v1[j] = acc[ai][bj][m][1][j] * fmaxf(b1[j], 1.f) * (1.f / (16.f * 255.f)); }
                    w[2 * bj] = pack4_fp8(v0[0], v0[1], v0[2], v0[3]); w[2 * bj + 1] = pack4_fp8(v1[0], v1[1], v1[2], v1[3]); }
                *(u32x4*)(merged8 + ro) = w; }
    }
};
template <> struct EpiBadj<EpiBranchF> { static constexpr bool v = true; };
template <> struct EpiMid<EpiBranchF> { static constexpr bool v = true; };
struct EpiResid {
    const float* base; float* out; float sc;
    __device__ __forceinline__ void operator()(const AccT& acc, const Unit& u, int wr, int wc, int fr, int fq) const {
        const int row0 = u.pm * BM + wr * 64 + fr, col0 = u.pn * BM + wc * 32 + 8 * fq;
#pragma unroll
        for (int ai = 0; ai < 2; ++ai)
#pragma unroll
            for (int m = 0; m < 4; ++m) { const size_t off = (size_t)(row0 + ai * HALF + m * 16) * 1024 + col0;
#pragma unroll
                for (int bj = 0; bj < 2; ++bj) {
                    const f32x4 b0 = *(const f32x4*)(base + off + bj * HALF), b1 = *(const f32x4*)(base + off + bj * HALF + 4);
                    *(f32x4*)(out + off + bj * HALF) = b0 + acc[ai][bj][m][0] * sc; *(f32x4*)(out + off + bj * HALF + 4) = b1 + acc[ai][bj][m][1] * sc; } }
    }
};
struct EpiResidHb {
    const bf16_t* base; bf16_t* out; unsigned char* hb; const float* g; float sc;
    __device__ __forceinline__ void operator()(const AccT& acc, const Unit& u, int wr, int wc, int fr, int fq) const {
        const int row0 = u.pm * BM + wr * 64 + fr, col0 = u.pn * BM + wc * 32 + 8 * fq;
        f32x4 gv[2][2];
#pragma unroll
        for (int bj = 0; bj < 2; ++bj)
#pragma unroll
            for (int n = 0; n < 2; ++n) gv[bj][n] = *(const f32x4*)(g + col0 + bj * HALF + 4 * n);
#pragma unroll
        for (int ai = 0; ai < 2; ++ai)
#pragma unroll
            for (int m = 0; m < 4; ++m) { const size_t off = (size_t)(row0 + ai * HALF + m * 16) * 1024 + col0;
#pragma unroll
                for (int bj = 0; bj < 2; ++bj) {
                    f32x4 b0, b1; unpack8(*(const u32x4*)(base + off + bj * HALF), b0, b1);
                    const f32x4 v0 = b0 + acc[ai][bj][m][0] * sc, v1 = b1 + acc[ai][bj][m][1] * sc;
                    *(u32x4*)(out + off + bj * HALF) = pack8(v0, v1);
                    const f32x4 s0 = v0 * gv[bj][0], s1 = v1 * gv[bj][1];
                    u32x2 w; w.x = pack4_fp8(s0[0], s0[1], s0[2], s0[3]); w.y = pack4_fp8(s1[0], s1[1], s1[2], s1[3]);
                    *(u32x2*)(hb + off + bj * HALF) = w; } }
    }
};
struct EpiResidSq {
    const float* base; bf16_t* out; unsigned char* hb; const float* g; float* rowss; float sc;
    __device__ __forceinline__ void operator()(const AccT& acc, const Unit& u, int wr, int wc, int fr, int fq) const {
        const int row0 = u.pm * BM + wr * 64 + fr, col0 = u.pn * BM + wc * 32 + 8 * fq;
        f32x4 gv[2][2];
#pragma unroll
        for (int bj = 0; bj < 2; ++bj)
#pragma unroll
            for (int n = 0; n < 2; ++n) gv[bj][n] = *(const f32x4*)(g + col0 + bj * HALF + 4 * n);
#pragma unroll
        for (int ai = 0; ai < 2; ++ai)
#pragma unroll
            for (int m = 0; m < 4; ++m) { const int row = row0 + ai * HALF + m * 16; const size_t off = (size_t)row * 1024 + col0; float ss = 0.f;
#pragma unroll
                for (int bj = 0; bj < 2; ++bj) {
                    const f32x4 v0 = *(const f32x4*)(base + off + bj * HALF) + acc[ai][bj][m][0] * sc, v1 = *(const f32x4*)(base + off + bj * HALF + 4) + acc[ai][bj][m][1] * sc;
                    *(u32x4*)(out + off + bj * HALF) = pack8(v0, v1);
                    ss += (v0[0] * v0[0] + v0[1] * v0[1]) + (v0[2] * v0[2] + v0[3] * v0[3]) + (v1[0] * v1[0] + v1[1] * v1[1]) + (v1[2] * v1[2] + v1[3] * v1[3]);
                    const f32x4 s0 = v0 * gv[bj][0], s1 = v1 * gv[bj][1];
                    u32x2 w; w.x = pack4_fp8(s0[0], s0[1], s0[2], s0[3]); w.y = pack4_fp8(s1[0], s1[1], s1[2], s1[3]);
                    *(u32x2*)(hb + off + bj * HALF) = w; }
                ss += __shfl_xor(ss, 16); ss += __shfl_xor(ss, 32);
                if (fq == 0) atomicAdd(rowss + row, ss); }
    }
};
struct EpiRowScale {
    bf16_t* O; int ldc; const float* rowss; float sc;
    __device__ __forceinline__ void operator()(const AccT& acc, const Unit& u, int wr, int wc, int fr, int fq) const {
        const int row0 = u.pm * BM + wr * 64 + fr, col0 = u.pn * BM + wc * 32 + 8 * fq;
#pragma unroll
        for (int ai = 0; ai < 2; ++ai)
#pragma unroll
            for (int m = 0; m < 4; ++m) { const int row = row0 + ai * HALF + m * 16; const float rs = rsqrtf(rowss[row] * (1.f / 1024.f) + EPS) * sc;
                bf16_t* rowp = O + (size_t)row * ldc + col0;
#pragma unroll
                for (int bj = 0; bj < 2; ++bj) *(u32x4*)(rowp + bj * HALF) = pack8(acc[ai][bj][m][0] * rs, acc[ai][bj][m][1] * rs); }
    }
};
struct EpiPlain {
    bf16_t* O; int ldc; float sc;
    __device__ __forceinline__ void operator()(const AccT& acc, const Unit& u, int wr, int wc, int fr, int fq) const {
        const int row0 = u.pm * BM + wr * 64 + fr, col0 = u.pn * BM + wc * 32 + 8 * fq;
#pragma unroll
        for (int ai = 0; ai < 2; ++ai)
#pragma unroll
            for (int m = 0; m < 4; ++m) { bf16_t* rowp = O + (size_t)(row0 + ai * HALF + m * 16) * ldc + col0;
#pragma unroll
                for (int bj = 0; bj < 2; ++bj) *(u32x4*)(rowp + bj * HALF) = pack8(acc[ai][bj][m][0] * sc, acc[ai][bj][m][1] * sc); }
    }
};
struct EpiSwiGLU {
    unsigned char* hmid; const float* sgate; const float* siv;
    __device__ __forceinline__ void operator()(const AccT& acc, const Unit& u, int wr, int wc, int fr, int fq) const {
        const int row0 = u.pm * BM + wr * 64 + fr, col0 = u.pn * HALF + wc * 32 + 8 * fq;
#pragma unroll
        for (int ai = 0; ai < 2; ++ai)
#pragma unroll
            for (int m = 0; m < 4; ++m) { const size_t row = (size_t)(row0 + ai * HALF + m * 16); const float gt = sgate[row] * 8.f, iv = siv[row];
                f32x4 v[2];
#pragma unroll
                for (int n = 0; n < 2; ++n)
#pragma unroll
                    for (int j = 0; j < 4; ++j) { const float a = acc[ai][0][m][n][j] * iv, b = acc[ai][1][m][n][j] * iv; v[n][j] = gt * a * sigmoidf_(a) * b; }
                u32x2 w; w.x = pack4_fp8(v[0][0], v[0][1], v[0][2], v[0][3]); w.y = pack4_fp8(v[1][0], v[1][1], v[1][2], v[1][3]);
                *(u32x2*)(hmid + row * DEXP + col0) = w; }
    }
};
struct EpiDown {
    unsigned char* y2; const int* sdest;
    __device__ __forceinline__ void operator()(const AccT& acc, const Unit& u, int wr, int wc, int fr, int fq) const {
        const int row0 = u.pm * BM + wr * 64 + fr, col0 = u.pn * BM + wc * 64 + 16 * fq;
#pragma unroll
        for (int ai = 0; ai < 2; ++ai)
#pragma unroll
            for (int m = 0; m < 4; ++m) { const int dest = sdest[row0 + ai * HALF + m * 16];
                if (dest >= 0) { u32x4 w;
#pragma unroll
                    for (int bj = 0; bj < 2; ++bj) { const f32x4 a = acc[ai][bj][m][0] * (1.f / 16.f), b = acc[ai][bj][m][1] * (1.f / 16.f);
                        w[2 * bj] = pack4_fp8(a[0], a[1], a[2], a[3]); w[2 * bj + 1] = pack4_fp8(b[0], b[1], b[2], b[3]); }
                    *(u32x4*)(y2 + (size_t)dest * 1024 + col0) = w; } }
    }
};
template <> struct EpiBadj<EpiDown> { static constexpr bool v = true; };
}

#define XB_TMO      128
#define XB_XCNT(j)  (256  + 64 * (j))
#define XB_XSUB(j)  (1280 + 64 * (j))
#define XB_XGEN(j)  (2304 + 64 * (j))
#define XB_TOP      3328
#define XB_TOPGEN   3392
#define XCD_BAR_WORDS 3456
#define XB_SPIN_CAP (1u << 18)
__device__ __forceinline__ unsigned xb_ld(unsigned* p)              { return __hip_atomic_load(p, __ATOMIC_RELAXED, __HIP_MEMORY_SCOPE_AGENT); }
__device__ __forceinline__ unsigned xb_add(unsigned* p, unsigned v) { return __hip_atomic_fetch_add(p, v, __ATOMIC_RELAXED, __HIP_MEMORY_SCOPE_AGENT); }
__device__ __forceinline__ unsigned xb_xcc_id() { return (unsigned)__builtin_amdgcn_s_getreg((3 << 11) | 20) & 0xFu; }
#define XB_SPIN(cond, bar) do { unsigned _sp = 0; while (cond) { __builtin_amdgcn_s_sleep(1); \
    if ((++_sp & 255u) == 0u) { if (xb_ld(&(bar)[XB_TMO])) break; if (_sp > XB_SPIN_CAP) { atomicAdd(&(bar)[XB_TMO], 1u); break; } } } } while (0)
struct XcdBarrier { unsigned* bar; unsigned x; volatile LAS unsigned* st; };
__device__ __forceinline__ XcdBarrier xcd_barrier_post(unsigned* bar, volatile LAS unsigned* st) {
    XcdBarrier b; b.bar = bar; b.x = xb_xcc_id(); b.st = st;
    if (threadIdx.x == 0) (void)xb_add(&bar[XB_XCNT(b.x)], 1u);
    return b;
}
__device__ __forceinline__ void xcd_barrier_complete(unsigned* bar, unsigned x, unsigned& nloc, unsigned& nx) {
    const unsigned G = gridDim.x * gridDim.y * gridDim.z;
    unsigned sum, cnt, mine, sp = 0u;
    for (;;) {
        sum = 0u; cnt = 0u; mine = 0u;
#pragma unroll
        for (unsigned j = 0; j < 16; ++j) { const unsigned c = xb_ld(&bar[XB_XCNT(j)]); sum += c; cnt += (c > 0u) ? 1u : 0u; mine = (j == x) ? c : mine; }
        if (sum == G) break;
        __builtin_amdgcn_s_sleep(1);
        if ((++sp & 255u) == 0u) { if (xb_ld(&bar[XB_TMO])) break; if (sp > XB_SPIN_CAP) { atomicAdd(&bar[XB_TMO], 1u); break; } }
    }
    nloc = mine > 0u ? mine : 1u; nx = cnt > 0u ? cnt : 1u;
}
__device__ __forceinline__ void xcd_barrier(const XcdBarrier& b) {
    asm volatile("s_waitcnt vmcnt(0)" ::: "memory");
    __syncthreads();
    if (threadIdx.x == 0) {
        unsigned* bar = b.bar;
        __builtin_amdgcn_s_waitcnt(0);
        unsigned nloc = b.st[0], nx = b.st[1];
        if (nloc == 0u) { xcd_barrier_complete(bar, b.x, nloc, nx); b.st[0] = nloc; b.st[1] = nx; }
        const unsigned old = xb_add(&bar[XB_XSUB(b.x)], 1u);
        const unsigned gen = old / nloc;
        if (old + 1u == (gen + 1u) * nloc) {
            __builtin_amdgcn_fence(__ATOMIC_RELEASE, "agent");
            asm volatile("s_waitcnt vmcnt(0)" ::: "memory");
            const unsigned og = xb_add(&bar[XB_TOP], 1u);
            const unsigned tg = og / nx;
            if (og + 1u == (tg + 1u) * nx) xb_add(&bar[XB_TOPGEN], 1u);
            else XB_SPIN(xb_ld(&bar[XB_TOPGEN]) == tg, bar);
            __builtin_amdgcn_fence(__ATOMIC_ACQUIRE, "agent");
            xb_add(&bar[XB_XGEN(b.x)], 1u);
            asm volatile("s_waitcnt vmcnt(0)" ::: "memory");
        } else {
            XB_SPIN(xb_ld(&bar[XB_XGEN(b.x)]) == gen, bar);
            __builtin_amdgcn_fence(__ATOMIC_ACQUIRE, "agent");
            asm volatile("s_waitcnt vmcnt(0)" ::: "memory");
        }
    }
    __syncthreads();
}

__device__ __forceinline__ void tr_item(const float* src, int src_ld, int nvalid, int n0, int k0, bf16_t* dst, int K, LAS float* scr, int lane) {
    const int nn = n0 + (lane & 31); const bool ok = nn < nvalid;
    float t[32];
#pragma unroll
    for (int i = 0; i < 32; ++i) t[i] = ok ? src[(size_t)(k0 + 2 * i + (lane >> 5)) * src_ld + nn] : 0.f;
#pragma unroll
    for (int i = 0; i < 32; ++i) scr[(2 * i + (lane >> 5)) * 33 + (lane & 31)] = t[i];
    LDS_WAIT(); asm volatile("" ::: "memory");
    const int c = lane & 7;
#pragma unroll
    for (int j = 0; j < 4; ++j) { const int n = (lane >> 3) + 8 * j; const LAS float* s = scr + (8 * c) * 33 + n;
        u32x4 o; o.x = cvt_pk_bf16(s[0 * 33], s[1 * 33]); o.y = cvt_pk_bf16(s[2 * 33], s[3 * 33]); o.z = cvt_pk_bf16(s[4 * 33], s[5 * 33]); o.w = cvt_pk_bf16(s[6 * 33], s[7 * 33]);
        *(u32x4*)(dst + (size_t)n * K + k0 + 8 * c) = o; }
    LDS_WAIT(); asm volatile("" ::: "memory");
}
__device__ __forceinline__ void tr_item8(const float* src, int src_ld, int nvalid, int n0, int k0, unsigned char* dst, int K, float scale, LAS float* scr, int lane) {
    const int nn = n0 + (lane & 31); const bool ok = nn < nvalid;
    float t[32];
#pragma unroll
    for (int i = 0; i < 32; ++i) t[i] = ok ? src[(size_t)(k0 + 2 * i + (lane >> 5)) * src_ld + nn] : 0.f;
#pragma unroll
    for (int i = 0; i < 32; ++i) scr[(2 * i + (lane >> 5)) * 33 + (lane & 31)] = t[i] * scale;
    LDS_WAIT(); asm volatile("" ::: "memory");
    const int c = lane & 7;
#pragma unroll
    for (int j = 0; j < 4; ++j) { const int n = (lane >> 3) + 8 * j; const LAS float* s = scr + (8 * c) * 33 + n;
        u32x2 o; o.x = pack4_fp8(s[0 * 33], s[1 * 33], s[2 * 33], s[3 * 33]); o.y = pack4_fp8(s[4 * 33], s[5 * 33], s[6 * 33], s[7 * 33]);
        *(u32x2*)(dst + (size_t)n * K + k0 + 8 * c) = o; }
    LDS_WAIT(); asm volatile("" ::: "memory");
}
__device__ __forceinline__ void rms_row_bf16(const float* xrow, const float* g, bf16_t* orow, int lane) {
    const f32x4* xr = (const f32x4*)xrow + lane; const f32x4* gr = (const f32x4*)g + lane;
    f32x4 v[4]; float s = 0.f;
#pragma unroll
    for (int j = 0; j < 4; ++j) { v[j] = xr[64 * j]; s += (v[j].x * v[j].x + v[j].y * v[j].y) + (v[j].z * v[j].z + v[j].w * v[j].w); }
    const float r = rsqrtf(wave_sum(s) * (1.f / 1024.f) + EPS);
    u32x2* o8 = (u32x2*)orow + lane;
#pragma unroll
    for (int j = 0; j < 4; ++j) { const f32x4 gv = gr[64 * j]; u32x2 w; w.x = cvt_pk_bf16(v[j].x * r * gv.x, v[j].y * r * gv.y); w.y = cvt_pk_bf16(v[j].z * r * gv.z, v[j].w * r * gv.w); o8[64 * j] = w; }
}

template <bool ALSO_BF16>
__device__ __forceinline__ void rms_rows4_fp8(const float* x0, size_t rstride, const float* g, unsigned char* o80, bf16_t* o0, int lane) {
    f32x4 v[4][4];
#pragma unroll
    for (int q = 0; q < 4; ++q)
#pragma unroll
        for (int j = 0; j < 4; ++j) v[q][j] = ((const f32x4*)(x0 + q * rstride) + lane)[64 * j];
    const f32x4* gr = (const f32x4*)g + lane;
    f32x4 gv[4];
#pragma unroll
    for (int j = 0; j < 4; ++j) gv[j] = gr[64 * j];
#pragma unroll
    for (int q = 0; q < 4; ++q) { float s = 0.f;
#pragma unroll
        for (int j = 0; j < 4; ++j) s += (v[q][j].x * v[q][j].x + v[q][j].y * v[q][j].y) + (v[q][j].z * v[q][j].z + v[q][j].w * v[q][j].w);
        const float r = rsqrtf(wave_sum(s) * (1.f / 1024.f) + EPS);
        unsigned* o4 = (unsigned*)(o80 + q * rstride) + lane; u32x2* o8 = (u32x2*)(o0 + q * rstride) + lane;
#pragma unroll
        for (int j = 0; j < 4; ++j) { const float a = v[q][j].x * r * gv[j].x, b = v[q][j].y * r * gv[j].y, c = v[q][j].z * r * gv[j].z, d = v[q][j].w * r * gv[j].w;
            o4[64 * j] = pack4_fp8(a, b, c, d);
            if (ALSO_BF16) { u32x2 w; w.x = cvt_pk_bf16(a, b); w.y = cvt_pk_bf16(c, d); o8[64 * j] = w; } } }
}
template <bool ALSO_BF16>
__device__ __forceinline__ void rms_row_fp8(const float* xrow, const float* g, unsigned char* orow8, bf16_t* orow, int lane) {
    const f32x4* xr = (const f32x4*)xrow + lane; const f32x4* gr = (const f32x4*)g + lane;
    f32x4 v[4]; float s = 0.f;
#pragma unroll
    for (int j = 0; j < 4; ++j) { v[j] = xr[64 * j]; s += (v[j].x * v[j].x + v[j].y * v[j].y) + (v[j].z * v[j].z + v[j].w * v[j].w); }
    const float r = rsqrtf(wave_sum(s) * (1.f / 1024.f) + EPS);
    unsigned* o4 = (unsigned*)orow8 + lane; u32x2* o8 = (u32x2*)orow + lane;
#pragma unroll
    for (int j = 0; j < 4; ++j) { const f32x4 gv = gr[64 * j]; const float a = v[j].x * r * gv.x, b = v[j].y * r * gv.y, c = v[j].z * r * gv.z, d = v[j].w * r * gv.w;
        o4[64 * j] = pack4_fp8(a, b, c, d);
        if (ALSO_BF16) { u32x2 w; w.x = cvt_pk_bf16(a, b); w.y = cvt_pk_bf16(c, d); o8[64 * j] = w; } }
}
__device__ __forceinline__ s16x4 vtr(const LAS unsigned char* p) { return __builtin_bit_cast(s16x4, __builtin_amdgcn_ds_read_tr16_b64_v4i16((LAS s16x4*)p)); }

template <int N> struct QReg { const bf16x8 (&q)[N]; __device__ __forceinline__ bf16x8 get(int ks) const { return q[ks]; } };
struct QLds { const LAS unsigned char* p; __device__ __forceinline__ bf16x8 get(int ks) const { return *(const LAS bf16x8*)(p + ks * 32); } };
__device__ __forceinline__ float fmax3_(float a, float b, float c) { float r; asm("v_max3_f32 %0, %1, %2, %3" : "=v"(r) : "v"(a), "v"(b), "v"(c)); return r; }
__device__ __forceinline__ float fmax2_(float a, float b) { float r; asm("v_max_f32_e32 %0, %1, %2" : "=v"(r) : "v"(a), "v"(b)); return r; }
__device__ __forceinline__ float fadd_(float a, float b) { float r; asm("v_add_f32_e32 %0, %1, %2" : "=v"(r) : "v"(a), "v"(b)); return r; }
struct TileSc { float c1, c2, tt, fh; unsigned m0, m1; bool diag; };
template <int DQK, int DV, bool PVDB, bool BIAS, bool MASKED, class QS>
__device__ __forceinline__ void attn_tile(const LAS unsigned char* Kt, const int kpitch, const LAS unsigned char* Vt, const int vpitch,
                                          const QS& qf, f32x16 (&o)[DV / 32], float& m_run, float& l_run, const TileSc& sc, const f32x16& kb0, const f32x16& kb1, const int lane) {
    const int r32 = lane & 31, hi = lane >> 5;
    f32x16 p0, p1;
    const LAS unsigned char* kp = Kt + r32 * kpitch + hi * 16;
    {
        const bf16x8 k0 = *(const LAS bf16x8*)(kp), k1 = *(const LAS bf16x8*)(kp + 32 * kpitch); const bf16x8 qv = qf.get(0);
        if (BIAS && !sc.diag) { p0 = __builtin_amdgcn_mfma_f32_32x32x16_bf16(k0, qv, kb0, 0, 0, 0); p1 = __builtin_amdgcn_mfma_f32_32x32x16_bf16(k1, qv, kb1, 0, 0, 0); }
        else { f32x16 z;
#pragma unroll
            for (int r = 0; r < 16; ++r) z[r] = 0.f;
            p0 = __builtin_amdgcn_mfma_f32_32x32x16_bf16(k0, qv, z, 0, 0, 0); p1 = __builtin_amdgcn_mfma_f32_32x32x16_bf16(k1, qv, z, 0, 0, 0); }
    }
#pragma unroll
    for (int ks = 1; ks < DQK / 16; ++ks) {
        const bf16x8 k0 = *(const LAS bf16x8*)(kp + ks * 32);
        const bf16x8 k1 = *(const LAS bf16x8*)(kp + 32 * kpitch + ks * 32);
        const bf16x8 qv = qf.get(ks);
        p0 = __builtin_amdgcn_mfma_f32_32x32x16_bf16(k0, qv, p0, 0, 0, 0);
        p1 = __builtin_amdgcn_mfma_f32_32x32x16_bf16(k1, qv, p1, 0, 0, 0);
    }
    float cm = sc.c1;
    if (BIAS && sc.diag) {
#pragma unroll
        for (int r = 0; r < 16; ++r) { const float k0 = sc.c2 * ((float)((r & 3) + 8 * (r >> 2)) + sc.fh), k1 = k0 + 32.f * sc.c2;
            p0[r] = p0[r] * sc.c1 + fminf(k0, sc.tt - k0); p1[r] = p1[r] * sc.c1 + fminf(k1, sc.tt - k1); }
        cm = 1.f;
    }
    if (MASKED) {
#pragma unroll
        for (int r = 0; r < 16; ++r) { const int cp = (r & 3) + 8 * (r >> 2);
            const unsigned t0 = (unsigned)__builtin_amdgcn_sbfe((int)sc.m0, cp, 1), t1 = (unsigned)__builtin_amdgcn_sbfe((int)sc.m1, cp, 1);
            p0[r] = __uint_as_float((__float_as_uint(p0[r]) & t0) | (0xff800000u & ~t0)); p1[r] = __uint_as_float((__float_as_uint(p1[r]) & t1) | (0xff800000u & ~t1)); }
    }
    asm volatile("s_nop 15\n\ts_nop 7" : "+v"(p0), "+v"(p1));
    float mx;
    { float a = fmax3_(p0[0], p0[1], p1[0]), b = fmax3_(p0[2], p0[3], p1[1]); a = fmax3_(a, p1[2], p1[3]);
#pragma unroll
      for (int r = 4; r < 16; r += 4) { a = fmax3_(a, p0[r], p0[r + 1]); b = fmax3_(b, p0[r + 2], p0[r + 3]); a = fmax3_(a, p1[r], p1[r + 1]); b = fmax3_(b, p1[r + 2], p1[r + 3]); }
      mx = fmax2_(a, b);
      const auto rr = __builtin_amdgcn_permlane32_swap(__float_as_uint(mx), __float_as_uint(mx), false, false);
      mx = fmax2_(__uint_as_float(rr[0]), __uint_as_float(rr[1])) * cm; }
    if (__any(mx > m_run)) {
        const float mnew = fmaxf(m_run, mx);
        const float alpha = fexp2(m_run - mnew);
        m_run = mnew; l_run *= alpha;
#pragma unroll
        for (int e = 0; e < DV / 32; ++e)
#pragma unroll
            for (int r = 0; r < 16; ++r) o[e][r] *= alpha;
    }
    const float nm = -m_run;
#pragma unroll
    for (int r = 0; r < 16; ++r) { p0[r] = fexp2(__builtin_fmaf(p0[r], cm, nm)); p1[r] = fexp2(__builtin_fmaf(p1[r], cm, nm)); }
    { float s0 = p0[0] + p1[0], s1 = p0[1] + p1[1], s2 = p0[2] + p1[2], s3 = p0[3] + p1[3];
#pragma unroll
      for (int r = 4; r < 16; r += 4) { s0 += p0[r] + p1[r]; s1 += p0[r + 1] + p1[r + 1]; s2 += p0[r + 2] + p1[r + 2]; s3 += p0[r + 3] + p1[r + 3]; }
      l_run += (s0 + s1) + (s2 + s3); }
    u32x4 pw[4];
#pragma unroll
    for (int i = 0; i < 4; ++i) { pw[0][i] = cvt_pk_bf16(p0[2 * i], p0[2 * i + 1]); pw[1][i] = cvt_pk_bf16(p0[8 + 2 * i], p0[8 + 2 * i + 1]);
                                  pw[2][i] = cvt_pk_bf16(p1[2 * i], p1[2 * i + 1]); pw[3][i] = cvt_pk_bf16(p1[8 + 2 * i], p1[8 + 2 * i + 1]); }
    const int g = lane >> 4, i16 = lane & 15;
    const LAS unsigned char* vp = Vt + (4 * hi + (i16 >> 2)) * vpitch + ((g & 1) * 16 + 4 * (i16 & 3)) * 2;
    constexpr int NE = DV / 32;
    if constexpr (!PVDB) {
#pragma unroll
        for (int s = 0; s < 4; ++s) {
            const bf16x8 pa = __builtin_bit_cast(bf16x8, pw[s]);
#pragma unroll
            for (int e = 0; e < NE; ++e) {
                const s16x4 lo = vtr(vp + (16 * s) * vpitch + e * 64), hh = vtr(vp + (16 * s + 8) * vpitch + e * 64);
                const bf16x8 vf = (bf16x8){lo[0], lo[1], lo[2], lo[3], hh[0], hh[1], hh[2], hh[3]};
                o[e] = __builtin_amdgcn_mfma_f32_32x32x16_bf16(vf, pa, o[e], 0, 0, 0);
            }
        }
        return;
    }
    s16x4 vlo[2][NE], vhi[2][NE];
#pragma unroll
    for (int e = 0; e < NE; ++e) { vlo[0][e] = vtr(vp + e * 64); vhi[0][e] = vtr(vp + 8 * vpitch + e * 64); }
#pragma unroll
    for (int s = 0; s < 4; ++s) {
        if (s + 1 < 4) {
#pragma unroll
            for (int e = 0; e < NE; ++e) { vlo[(s + 1) & 1][e] = vtr(vp + (16 * (s + 1)) * vpitch + e * 64); vhi[(s + 1) & 1][e] = vtr(vp + (16 * (s + 1) + 8) * vpitch + e * 64); }
        }
        const bf16x8 pa = __builtin_bit_cast(bf16x8, pw[s]);
#pragma unroll
        for (int e = 0; e < NE; ++e) {
            const s16x4 lo = vlo[s & 1][e], hh = vhi[s & 1][e];
            const bf16x8 vf = (bf16x8){lo[0], lo[1], lo[2], lo[3], hh[0], hh[1], hh[2], hh[3]};
            o[e] = __builtin_amdgcn_mfma_f32_32x32x16_bf16(vf, pa, o[e], 0, 0, 0);
        }
    }
}
template <int ROWB> struct TileRegs { u32x4 v[(64 * ROWB / 16) / 512]; };
template <int ROWB>
__device__ __forceinline__ void tile_load(TileRegs<ROWB>& t, const bf16_t* gsrc, size_t gpitch_el, int tid) {
    constexpr int CPR = ROWB / 16, TOTAL = 64 * CPR;
#pragma unroll
    for (int c = 0; c < TOTAL / 512; ++c) { const int idx = tid + c * 512, row = idx / CPR, ch = idx % CPR;
        t.v[c] = *(const u32x4*)(gsrc + (size_t)row * gpitch_el + ch * 8); }
}
template <int ROWB>
__device__ __forceinline__ void tile_store(const TileRegs<ROWB>& t, LAS unsigned char* dst, int lpitch, int tid) {
    constexpr int CPR = ROWB / 16, TOTAL = 64 * CPR;
#pragma unroll
    for (int c = 0; c < TOTAL / 512; ++c) { const int idx = tid + c * 512, row = idx / CPR, ch = idx % CPR;
        *(LAS u32x4*)(dst + row * lpitch + ch * 16) = t.v[c]; }
}
template <int ROWB>
__device__ __forceinline__ void stage_tile(const bf16_t* gsrc, size_t gpitch_el, LAS unsigned char* dst, int lpitch, int tid) {
    constexpr int CPR = ROWB / 16, TOTAL = 64 * CPR;
#pragma unroll
    for (int c = 0; c < TOTAL / 512; ++c) { const int idx = tid + c * 512, row = idx / CPR, ch = idx % CPR;
        const u32x4 v = *(const u32x4*)(gsrc + (size_t)row * gpitch_el + ch * 8);
        *(LAS u32x4*)(dst + row * lpitch + ch * 16) = v; }
}
template <int NE>
__device__ __forceinline__ void store_ot(const f32x16 (&o)[NE], float scale, bf16_t* rowp, int hi) {
#pragma unroll
    for (int e = 0; e < NE; ++e)
#pragma unroll
        for (int g4 = 0; g4 < 4; ++g4) { u32x2 w; w.x = cvt_pk_bf16(o[e][4 * g4] * scale, o[e][4 * g4 + 1] * scale); w.y = cvt_pk_bf16(o[e][4 * g4 + 2] * scale, o[e][4 * g4 + 3] * scale);
            *(u32x2*)(rowp + 32 * e + 8 * g4 + 4 * hi) = w; }
}

template <int NE>
__device__ __forceinline__ void store_ot8(const f32x16 (&o)[NE], float scale, unsigned char* rowp, int hi) {
#pragma unroll
    for (int e = 0; e < NE; ++e)
#pragma unroll
        for (int g4 = 0; g4 < 4; ++g4) *(unsigned*)(rowp + 32 * e + 8 * g4 + 4 * hi) = pack4_fp8(o[e][4 * g4] * scale, o[e][4 * g4 + 1] * scale, o[e][4 * g4 + 2] * scale, o[e][4 * g4 + 3] * scale);
}
template <int NE>
__device__ __forceinline__ void rows_out8(const LAS unsigned char* scr, unsigned char* grow0, const size_t gpitch, const int lane) {
    constexpr int PITCH = 32 * NE + 16, CH = 2 * NE, RPI = 64 / CH;
    const int rr = lane / CH, ch = lane % CH;
#pragma unroll
    for (int it = 0; it < 32 / RPI; ++it) { const int row = it * RPI + rr;
        const u32x4 v = *(const LAS u32x4*)(scr + row * PITCH + ch * 16); *(u32x4*)(grow0 + (size_t)row * gpitch + ch * 16) = v; }
}
template <int NE>
__device__ __forceinline__ void store_ot8_rows(const f32x16 (&o)[NE], float scale, LAS unsigned char* scr, unsigned char* grow0, const size_t gpitch, const int lane) {
    constexpr int PITCH = 32 * NE + 16; const int r32 = lane & 31, hi = lane >> 5;
#pragma unroll
    for (int e = 0; e < NE; ++e)
#pragma unroll
        for (int g4 = 0; g4 < 4; ++g4) *(LAS unsigned*)(scr + r32 * PITCH + 32 * e + 8 * g4 + 4 * hi) = pack4_fp8(o[e][4 * g4] * scale, o[e][4 * g4 + 1] * scale, o[e][4 * g4 + 2] * scale, o[e][4 * g4 + 3] * scale);
    rows_out8<NE>(scr, grow0, gpitch, lane);
}
__device__ __forceinline__ void make_kb(f32x16& kb0, f32x16& kb1, float c1, float c2, int hi) {
#pragma unroll
    for (int r = 0; r < 16; ++r) { kb0[r] = c2 * (float)((r & 3) + 8 * (r >> 2) + 4 * hi) / c1; kb1[r] = kb0[r] + 32.f * c2 / c1; }
}

__device__ __forceinline__ void diffattn_unit(const bf16_t* proj, unsigned char* ya, const float* subln, const float lam, const int b, const int h, const int qb,
                                              LAS unsigned char* lds, const int tid_in) {
    int tid = tid_in; asm volatile("" : "+v"(tid));
    const int wave = __builtin_amdgcn_readfirstlane(tid >> 6), lane = tid & 63, r32 = lane & 31, hi = lane >> 5;
    const int sb = wave & 3, mm = wave >> 2;
    const LAS float* subl = (const LAS float*)(lds + 131072); (void)subln;
    const int t0 = qb * 128 + sb * 32;
    const size_t rowbase = (size_t)b * SEQ;
    bf16x8 qf[4];
    { const bf16_t* qp = proj + (rowbase + t0 + r32) * PW + C_QA + h * 128 + mm * 64 + hi * 8;
#pragma unroll
      for (int ks = 0; ks < 4; ++ks) qf[ks] = *(const bf16x8*)(qp + ks * 16); }
    f32x16 o[4];
#pragma unroll
    for (int e = 0; e < 4; ++e)
#pragma unroll
        for (int r = 0; r < 16; ++r) o[e][r] = 0.f;
    float m_run = -1e30f, l_run = 0.f;
    const int nt = 2 * qb + 2, ntw = (t0 >> 6) + 1;
    constexpr int KP = 272, VP = 320, KB = 64 * KP, BUFB = 64 * KP + 64 * VP;
    const float c2 = exp2f(-2.f * (float)(h + 1)) * LOG2E;
    TileSc sf; sf.c1 = 0.125f * LOG2E; sf.c2 = c2; sf.fh = (float)(4 * hi); sf.tt = 2.f * c2 * (float)((t0 & 63) + r32); sf.m0 = 0u; sf.m1 = 0u; sf.diag = false;
    const bf16_t* src = proj + rowbase * PW + h * 128;
    TileRegs<256> kr, vr;
    { const bf16_t* s0 = src + (size_t)(64 * (nt - 1)) * PW; tile_load<256>(kr, s0 + C_KA, PW, tid); tile_load<256>(vr, s0 + C_VA, PW, tid); }
    tile_store<256>(kr, lds, KP, tid); tile_store<256>(vr, lds + KB, VP, tid);
#pragma unroll
    for (int ks = 0; ks < 4; ++ks) asm volatile("" : "+v"(qf[ks]));
    __syncthreads();
    for (int it = 0; it < nt; ++it) {
        const int j = nt - 1 - it;
        LAS unsigned char* kb = lds + (it & 1) * BUFB; LAS unsigned char* nb = lds + ((it + 1) & 1) * BUFB;
        if (j > 0) { const bf16_t* sn = src + (size_t)(64 * (j - 1)) * PW; tile_load<256>(kr, sn + C_KA, PW, tid); tile_load<256>(vr, sn + C_VA, PW, tid); }
        if (j < ntw) { sf.diag = (j == ntw - 1);
            float kq = c2 / sf.c1; asm volatile("" : "+v"(kq));
            const float kh = kq * sf.fh;
            f32x16 kb0, kb1;
#pragma unroll
            for (int r = 0; r < 16; ++r) { kb0[r] = kq * (float)((r & 3) + 8 * (r >> 2)) + kh; kb1[r] = kq * (float)((r & 3) + 8 * (r >> 2) + 32) + kh; }
            attn_tile<64, 128, true, true, false>(kb + mm * 128, KP, kb + KB, VP, QReg<4>{qf}, o, m_run, l_run, sf, kb0, kb1, lane); m_run += 64.f * c2; }
        if (j > 0) { tile_store<256>(kr, nb, KP, tid); tile_store<256>(vr, nb + KB, VP, tid); }
        __syncthreads();
    }
    const float ltot = xor32_sum(l_run);
    const float inv = 1.f / ltot;
    LAS float* X = (LAS float*)lds + sb * 4096;
    if (mm == 1) {
#pragma unroll
        for (int e = 0; e < 4; ++e)
#pragma unroll
            for (int r = 0; r < 16; ++r) X[(32 * e + crow(r, hi)) * 32 + r32] = o[e][r] * inv;
    }
    __syncthreads();
    if (mm == 0) {
        float ss = 0.f;
#pragma unroll
        for (int e = 0; e < 4; ++e) {
#pragma unroll
            for (int r = 0; r < 16; ++r) { const float d = o[e][r] * inv - lam * X[(32 * e + crow(r, hi)) * 32 + r32]; o[e][r] = d; ss += d * d; }
            __builtin_amdgcn_sched_barrier(0);
        }
        ss = xor32_sum(ss);
        const float rn = rsqrtf(ss * (1.f / 128.f) + EPS) * 0.8f * 4.f;
        LAS unsigned char* scr = (LAS unsigned char*)X;
#pragma unroll
        for (int e = 0; e < 4; ++e) {
#pragma unroll
            for (int g4 = 0; g4 < 4; ++g4) { const f32x4 sv = *(const LAS f32x4*)(subl + 32 * e + 8 * g4 + 4 * hi);
                *(LAS unsigned*)(scr + r32 * 144 + 32 * e + 8 * g4 + 4 * hi) = pack4_fp8(o[e][4 * g4] * rn * sv[0], o[e][4 * g4 + 1] * rn * sv[1], o[e][4 * g4 + 2] * rn * sv[2], o[e][4 * g4 + 3] * rn * sv[3]); }
            __builtin_amdgcn_sched_barrier(0);
        }
        rows_out8<4>(scr, ya + (rowbase + t0) * 1024 + h * 128, 1024, lane);
    }
    __syncthreads();
}

__device__ __forceinline__ unsigned f32_to_sortable16(float x) {
    const _Float16 hx = (_Float16)x; const unsigned b = (unsigned)__builtin_bit_cast(unsigned short, hx);
    return (b & 0x8000u) ? (~b & 0xffffu) : (b | 0x8000u);
}
__device__ __forceinline__ unsigned pk_count_gt(unsigned cnt, unsigned x, unsigned c) {
    unsigned d;
    asm("v_pk_sub_u16 %0, %1, %2 clamp" : "=v"(d) : "v"(x), "v"(c));
    asm("v_pk_min_u16 %0, %1, 1 op_sel_hi:[1,0]" : "=v"(d) : "v"(d));
    asm("v_pk_add_u16 %0, %1, %2" : "=v"(cnt) : "v"(cnt), "v"(d));
    return cnt;
}
__device__ __forceinline__ unsigned pk_wrapsum(unsigned acc, unsigned x, unsigned c2) {
    unsigned d;
    asm("v_pk_sub_u16 %0, %1, %2" : "=v"(d) : "v"(c2), "v"(x));
    asm("v_sad_u16 %0, %1, 0, %2" : "=v"(acc) : "v"(d), "v"(acc));
    return acc;
}
__device__ __forceinline__ unsigned nib_gt(unsigned x, unsigned y, unsigned c2) {
    unsigned gx, gy;
    asm("v_pk_sub_u16 %0, %1, %2 clamp" : "=v"(gx) : "v"(x), "v"(c2)); asm("v_pk_min_u16 %0, %1, 1 op_sel_hi:[1,0]" : "=v"(gx) : "v"(gx));
    asm("v_pk_sub_u16 %0, %1, %2 clamp" : "=v"(gy) : "v"(y), "v"(c2)); asm("v_pk_min_u16 %0, %1, 1 op_sel_hi:[1,0]" : "=v"(gy) : "v"(gy));
    return __builtin_amdgcn_udot4(__builtin_amdgcn_perm(gy, gx, 0x06040200u), 0x08040201u, 0u, false);
}
__device__ __forceinline__ int grp16_sum(int v) {
    v += __builtin_amdgcn_update_dpp(0, v, 0x128, 0xf, 0xf, false);
    v += __builtin_amdgcn_update_dpp(0, v, 0x124, 0xf, 0xf, false);
    v += __builtin_amdgcn_update_dpp(0, v, 0x122, 0xf, 0xf, false);
    v += __builtin_amdgcn_update_dpp(0, v, 0x121, 0xf, 0xf, false);
    return v;
}
__device__ __forceinline__ int grp16_incl_scan(int v) {
    v += __builtin_amdgcn_update_dpp(0, v, 0x111, 0xf, 0xf, true);
    v += __builtin_amdgcn_update_dpp(0, v, 0x112, 0xf, 0xf, true);
    v += __builtin_amdgcn_update_dpp(0, v, 0x114, 0xf, 0xf, true);
    v += __builtin_amdgcn_update_dpp(0, v, 0x118, 0xf, 0xf, true);
    return v;
}

__device__ __forceinline__ void dsa_unit(const bf16_t* proj, unsigned char* yb, const int b, const int qblk, LAS unsigned char* lds, const int tid_in) {
    int tid = tid_in; asm volatile("" : "+v"(tid));
    const int wave = __builtin_amdgcn_readfirstlane(tid >> 6), lane = tid & 63, r32 = lane & 31, hi = lane >> 5;
    const int t0 = qblk * 32, nt = (t0 >> 6) + 1;
    const size_t rowbase = (size_t)b * SEQ;
    const bool need_sel = nt > 4;
    LAS unsigned* mask = (LAS unsigned*)(lds + MASK_OFF);
    bf16x8 qf[4]; TileRegs<128> kr, vr;
#define DSA_FIRST_LOADS() do { const bf16_t* qp_ = proj + (rowbase + t0 + r32) * PW + C_QB + wave * 64 + hi * 8; \
        _Pragma("unroll") for (int ks = 0; ks < 4; ++ks) qf[ks] = *(const bf16x8*)(qp_ + ks * 16); \
        const bf16_t* s0_ = proj + rowbase * PW + (size_t)(64 * (nt - 1)) * PW; tile_load<128>(kr, s0_ + C_KB, PW, tid); tile_load<128>(vr, s0_ + C_VB, PW, tid); } while (0)
    if (!need_sel) DSA_FIRST_LOADS();
    if (need_sel) for (int rep2_ = 0; rep2_ < REPS(102); ++rep2_) {
        for (int i = tid; i < 32 * MASK_PITCH_W; i += 512) mask[i] = 0u;
        const int rs8 = (nt | 1) * 8; const float inv_nt = 1.f / (float)nt;
        {
            bf16x8 qi[4][4]; float w[4];
            const bf16_t* qrow = proj + (rowbase + t0 + r32) * PW;
            LAS unsigned char* QI = lds + QIDX_OFF;
            { const bf16_t* qsrc = proj + (rowbase + t0) * PW + C_QI;
#pragma unroll
              for (int c = 0; c < 2; ++c) { const int idx = tid + c * 512, row = idx >> 5, ch = idx & 31;
                  const u32x4 v = *(const u32x4*)(qsrc + (size_t)row * PW + ch * 8); *(LAS u32x4*)(QI + row * 528 + ch * 16) = v; } }
#pragma unroll
            for (int hh = 0; hh < 4; ++hh) w[hh] = bf2f(qrow[C_WI + hh]) * 0.0625f;
            __syncthreads();
#pragma unroll
            for (int hh = 0; hh < 4; ++hh)
#pragma unroll
                for (int ks = 0; ks < 4; ++ks) qi[hh][ks] = *(const LAS bf16x8*)(QI + r32 * 528 + (hh * 64 + ks * 16 + hi * 8) * 2);
            const bf16_t* kbase = proj + (rowbase + r32) * PW + C_KI + hi * 8;
            bf16x8 kf[4], kn[4];
            if (wave < 2 * nt) {
#pragma unroll
                for (int ks = 0; ks < 4; ++ks) kf[ks] = *(const bf16x8*)(kbase + (size_t)(32 * wave) * PW + ks * 16); }
#pragma unroll 1
            for (int it = wave; it < 2 * nt; it += 8) {
                const int j = it >> 1, blk = it & 1; const int nx = (it + 8 < 2 * nt) ? it + 8 : it;
#pragma unroll
                for (int ks = 0; ks < 4; ++ks) kn[ks] = *(const bf16x8*)(kbase + (size_t)(32 * nx) * PW + ks * 16);
                f32x16 isc;
#pragma unroll
                for (int r = 0; r < 16; ++r) isc[r] = 0.f;
#pragma unroll
                for (int hh = 0; hh < 4; ++hh) { f32x16 a;
#pragma unroll
                    for (int r = 0; r < 16; ++r) a[r] = 0.f;
#pragma unroll
                    for (int ks = 0; ks < 4; ++ks) a = __builtin_amdgcn_mfma_f32_32x32x16_bf16(kf[ks], qi[hh][ks], a, 0, 0, 0);
#pragma unroll
                    for (int r = 0; r < 16; ++r) isc[r] += w[hh] * fmaxf(a[r], 0.f); }
#pragma unroll
                for (int g4 = 0; g4 < 4; ++g4) {
                    const unsigned u0 = f32_to_sortable16(isc[4 * g4]), u1 = f32_to_sortable16(isc[4 * g4 + 1]), u2 = f32_to_sortable16(isc[4 * g4 + 2]), u3 = f32_to_sortable16(isc[4 * g4 + 3]);
                    const int kq = 16 * j + 8 * blk + 2 * g4 + hi;
                    const int rg = (int)(((float)kq + 0.5f) * inv_nt);
                    u32x2 w2; w2.x = u0 | (u1 << 16); w2.y = u2 | (u3 << 16);
                    *(LAS u32x2*)(lds + r32 * ISC_PITCH + rg * rs8 + (kq - rg * nt) * 8) = w2;
                }
#pragma unroll
                for (int ks = 0; ks < 4; ++ks) kf[ks] = kn[ks];
            }
        }
        DSA_FIRST_LOADS();
        __syncthreads();
        {
            const int q = tid >> 4, sub = tid & 15;
            const LAS unsigned char* base = lds + q * ISC_PITCH + sub * rs8;
            u32x2 v[32];
#pragma unroll
            for (int i = 0; i < 32; ++i) { if (i < nt) v[i] = *(const LAS u32x2*)(base + 8 * i); else { v[i].x = 0u; v[i].y = 0u; } }
            unsigned T = 0u;
            int xtot, xthr;
            { unsigned xs = 0u;
#pragma unroll
              for (int i = 0; i < 32; ++i) if (i < nt) { asm("v_sad_u16 %0, %1, 0, %2" : "=v"(xs) : "v"(v[i].x), "v"(xs)); asm("v_sad_u16 %0, %1, 0, %2" : "=v"(xs) : "v"(v[i].y), "v"(xs)); }
              xthr = (int)xs; xtot = grp16_sum((int)xs); }
            const int ntot = 64 * nt;
            {
                unsigned tb[32];
#pragma unroll
                for (int i = 0; i < 32; ++i) tb[i] = (i < nt) ? __builtin_amdgcn_perm(v[i].y, v[i].x, 0x07050301u) : 0u;
                unsigned Th = 0u;
                for (int bit = 7; bit >= 0; --bit) {
                    const unsigned ch = Th | (1u << bit); const unsigned c4 = ch * 0x01010101u, m4 = (ch - 1u) * 0x01010101u; unsigned a1 = 0u, a2 = 0u;
#pragma unroll
                    for (int i = 0; i < 32; ++i) if (i < nt) { asm("v_sad_u8 %0, %1, %2, %3" : "=v"(a1) : "v"(tb[i]), "v"(m4), "v"(a1)); asm("v_sad_u8 %0, %1, %2, %3" : "=v"(a2) : "v"(tb[i]), "v"(c4), "v"(a2)); }
                    const int cnt = (ntot + grp16_sum((int)a1 - (int)a2)) >> 1;
                    if (cnt >= 256) Th = ch;
                }
                const unsigned th2 = (Th << 8) * 0x10001u;
#pragma unroll
                for (int i = 0; i < 32; ++i) if (i < nt) { unsigned zx, zy;
                    asm("v_pk_sub_u16 %0, %1, %2 clamp" : "=v"(zx) : "v"(v[i].x), "v"(th2)); asm("v_pk_min_u16 %0, %1, %2" : "=v"(zx) : "v"(zx), "v"(0x00ff00ffu));
                    asm("v_pk_sub_u16 %0, %1, %2 clamp" : "=v"(zy) : "v"(v[i].y), "v"(th2)); asm("v_pk_min_u16 %0, %1, %2" : "=v"(zy) : "v"(zy), "v"(0x00ff00ffu));
                    tb[i] = __builtin_amdgcn_perm(zy, zx, 0x06040200u); }
                unsigned Tl = 0u;
                for (int bit = 7; bit >= 0; --bit) {
                    const unsigned cl = Tl | (1u << bit); const unsigned c4 = cl * 0x01010101u, m4 = (cl - 1u) * 0x01010101u; unsigned a1 = 0u, a2 = 0u;
#pragma unroll
                    for (int i = 0; i < 32; ++i) if (i < nt) { asm("v_sad_u8 %0, %1, %2, %3" : "=v"(a1) : "v"(tb[i]), "v"(m4), "v"(a1)); asm("v_sad_u8 %0, %1, %2, %3" : "=v"(a2) : "v"(tb[i]), "v"(c4), "v"(a2)); }
                    const int cnt = (ntot + grp16_sum((int)a1 - (int)a2)) >> 1;
                    if (cnt >= 256) Tl = cl;
                }
                T = (Th << 8) | Tl;
            }
            int cgt, ceq;
            { unsigned sg = 0u, se = 0u; const unsigned tp = T * 0x10001u, tm1 = (T - 1u) * 0x10001u;
#pragma unroll
              for (int i = 0; i < 32; ++i) if (i < nt) { sg = pk_wrapsum(sg, v[i].x, tp); sg = pk_wrapsum(sg, v[i].y, tp); se = pk_wrapsum(se, v[i].x, tm1); se = pk_wrapsum(se, v[i].y, tm1); }
              cgt = ((int)sg - 4 * nt * (int)T + xthr) >> 16; ceq = (((int)se - 4 * nt * ((int)T - 1) + xthr) >> 16) - cgt; }
            const int need = 256 - grp16_sum(cgt);
            int rem = need - (grp16_incl_scan(ceq) - ceq);
            LAS unsigned* mrow = mask + q * MASK_PITCH_W;
            const unsigned tp2 = T * 0x10001u, tm2 = (T - 1u) * 0x10001u;
#pragma unroll
            for (int i = 0; i < 32; ++i) if (i < nt) {
                const unsigned gt = nib_gt(v[i].x, v[i].y, tp2), eqn = nib_gt(v[i].x, v[i].y, tm2) ^ gt;
                unsigned nib = gt;
                if (__any(eqn != 0u)) {
                    unsigned t = eqn;
#pragma unroll
                    for (int e = 0; e < 4; ++e) { const unsigned low = t & (0u - t); nib |= (rem > 0) ? low : 0u; rem -= (low != 0u) ? 1 : 0; t ^= low; }
                }
                const int pos = sub * nt + i;
                if (nib) atomicOr((unsigned*)(mrow + (pos >> 3)), nib << ((pos & 7) * 4));
            }
        }
        __syncthreads();
    }
#undef DSA_FIRST_LOADS
    f32x16 o[2];
#pragma unroll
    for (int e = 0; e < 2; ++e)
#pragma unroll
        for (int r = 0; r < 16; ++r) o[e][r] = 0.f;
    float m_run = -1e30f, l_run = 0.f;
    constexpr int KP = 144, VP = 192, KB = 64 * KP, BUFB = 64 * KP + 64 * VP;
    const float c2 = exp2f(-(float)(wave + 1)) * LOG2E;
    TileSc sf; sf.c1 = 0.125f * LOG2E; sf.c2 = c2; sf.fh = (float)(4 * hi); sf.tt = 2.f * c2 * (float)((t0 & 63) + r32); sf.m0 = 0xffffffffu; sf.m1 = 0xffffffffu; sf.diag = false;
    f32x16 kb0, kb1; make_kb(kb0, kb1, sf.c1, c2, hi);
    const bf16_t* src = proj + rowbase * PW;
    tile_store<128>(kr, lds, KP, tid); tile_store<128>(vr, lds + KB, VP, tid);
#pragma unroll
    for (int ks = 0; ks < 4; ++ks) asm volatile("" : "+v"(qf[ks]));
    __syncthreads();
    for (int it = 0; it < nt; ++it) {
        const int j = nt - 1 - it;
        LAS unsigned char* kb = lds + (it & 1) * BUFB; LAS unsigned char* nb = lds + ((it + 1) & 1) * BUFB;
        if (j > 0) { const bf16_t* sn = src + (size_t)(64 * (j - 1)) * PW; tile_load<128>(kr, sn + C_KB, PW, tid); tile_load<128>(vr, sn + C_VB, PW, tid); }
        if (need_sel) { const u32x2 mw = *(const LAS u32x2*)(mask + r32 * MASK_PITCH_W + 2 * j); sf.m0 = mw.x >> (4 * hi); sf.m1 = mw.y >> (4 * hi); }
        sf.diag = (it == 0);
        attn_tile<64, 64, true, true, true>(kb, KP, kb + KB, VP, QReg<4>{qf}, o, m_run, l_run, sf, kb0, kb1, lane); m_run += 64.f * c2;
        if (j > 0) { tile_store<128>(kr, nb, KP, tid); tile_store<128>(vr, nb + KB, VP, tid); }
#if REP_PHASE == 301
        __syncthreads();
        if (j > 0) { const bf16_t* sn = src + (size_t)(64 * (j - 1)) * PW; asm volatile("" : "+v"(kr.v[0]), "+v"(vr.v[0])); tile_load<128>(kr, sn + C_KB, PW, tid); tile_load<128>(vr, sn + C_VB, PW, tid);
            tile_store<128>(kr, nb, KP, tid); tile_store<128>(vr, nb + KB, VP, tid); }
#endif
#if REP_PHASE == 302
        { f32x16 o2[2]; float m2 = m_run, l2 = l_run; o2[0] = o[0]; o2[1] = o[1];
          attn_tile<64, 64, true, true, true>(kb, KP, kb + KB, VP, QReg<4>{qf}, o2, m2, l2, sf, kb0, kb1, lane);
          asm volatile("" :: "v"(o2[0]), "v"(o2[1]), "v"(m2), "v"(l2)); }
#endif
        __syncthreads();
    }
    const float ltot = xor32_sum(l_run);
    store_ot8_rows<2>(o, 8.f / ltot, lds + wave * 2560, yb + (rowbase + t0) * 1024 + wave * 64, 1024, lane);
    __syncthreads();
}

__device__ __forceinline__ void cross_unit(const bf16_t* qc, const bf16_t* kvc, unsigned char* oc, const int b, const int hx, const int qb, LAS unsigned char* lds, const int tid_in) {
    int tid = tid_in; asm volatile("" : "+v"(tid));
    const int wave = __builtin_amdgcn_readfirstlane(tid >> 6), lane = tid & 63, r32 = lane & 31, hi = lane >> 5;
    const int sb = wave & 3, eh = wave >> 2;
    const int t0 = qb * 128 + sb * 32;
    const size_t rowbase = (size_t)b * SEQ;
    constexpr int QP = 528, KP = 528, VP = 576, QB_ = 128 * QP, KB = 64 * KP;
    LAS unsigned char* Qs = lds; LAS unsigned char* Kt = lds + QB_; LAS unsigned char* Vt = Kt + KB;
    const bf16_t* src = kvc + (size_t)b * NMEM * 2048 + hx * 256;
    TileRegs<512> kr, vr;
    { const bf16_t* s0 = src + (size_t)(64 * (qb & 3)) * 2048; tile_load<512>(kr, s0, 2048, tid); tile_load<512>(vr, s0 + 1024, 2048, tid); }
    { const bf16_t* qsrc = qc + (rowbase + qb * 128) * 1024 + hx * 256;
#pragma unroll
      for (int c = 0; c < 8; ++c) { const int idx = tid + c * 512, row = idx >> 5, ch = idx & 31;
          const u32x4 v = *(const u32x4*)(qsrc + (size_t)row * 1024 + ch * 8); *(LAS u32x4*)(Qs + row * QP + ch * 16) = v; } }
    tile_store<512>(kr, Kt, KP, tid); tile_store<512>(vr, Vt, VP, tid);
    __syncthreads();
    f32x16 o[4];
#pragma unroll
    for (int e = 0; e < 4; ++e)
#pragma unroll
        for (int r = 0; r < 16; ++r) o[e][r] = 0.f;
    float m_run = -1e30f, l_run = 0.f;
    TileSc sf; sf.c1 = 0.0625f * LOG2E; sf.c2 = 0.f; sf.tt = 0.f; sf.fh = 0.f; sf.m0 = 0u; sf.m1 = 0u; sf.diag = false;
    f32x16 kbz;
#pragma unroll
    for (int r = 0; r < 16; ++r) kbz[r] = 0.f;
    const QLds ql{Qs + (sb * 32 + r32) * QP + hi * 16};
    for (int j = 0; j < 4; ++j) {
        if (j + 1 < 4) { const bf16_t* sn = src + (size_t)(64 * ((qb + j + 1) & 3)) * 2048; tile_load<512>(kr, sn, 2048, tid); tile_load<512>(vr, sn + 1024, 2048, tid); }
        attn_tile<256, 128, true, false, false>(Kt, KP, Vt + eh * 256, VP, ql, o, m_run, l_run, sf, kbz, kbz, lane);
        __syncthreads();
        if (j + 1 < 4) { tile_store<512>(kr, Kt, KP, tid); tile_store<512>(vr, Vt, VP, tid); __syncthreads(); }
    }
    const float ltot = xor32_sum(l_run);
    store_ot8_rows<4>(o, 16.f / ltot, lds + wave * 4608, oc + (rowbase + t0) * 1024 + hx * 256 + eh * 128, 1024, lane);
    __syncthreads();
}

__device__ __forceinline__ void moe_tables(const int* hist, LAS int* tab, const int tb_limit, const int tid) {
    const int e = tid & 31, part = tid >> 5;
    int tot = 0, pre = 0;
    for (int tb = part; tb < 256; tb += 16) { const int hv = hist[tb * 32 + e]; tot += hv; pre += (tb < tb_limit) ? hv : 0; }
    tab[128 + part * 32 + e] = tot; tab[1024 + part * 32 + e] = pre;
    __syncthreads();
    if (tid < 32) { int a = 0, p = 0;
#pragma unroll
        for (int k = 0; k < 16; ++k) { a += tab[128 + k * 32 + tid]; p += tab[1024 + k * 32 + tid]; }
        tab[tid] = a; tab[640 + tid] = p; }
    __syncthreads();
    if (tid == 0) { int ps = 0, rb = 0;
        for (int k = 0; k < 32; ++k) { tab[32 + k] = ps; tab[72 + k] = rb; const int nb = (tab[k] + 255) >> 8; ps += nb * 256; rb += nb; }
        tab[64] = ps; tab[104] = rb; tab[108] = rb; }
    __syncthreads();
    { const int n_rb = tab[108]; LAS unsigned char* rb2e = (LAS unsigned char*)(tab + 1600);
      for (int rb = tid; rb < n_rb; rb += 512) { int ee = 0;
#pragma unroll 4
          for (int k = 1; k < 32; ++k) ee += (rb >= tab[72 + k]) ? 1 : 0;
          rb2e[rb] = (unsigned char)ee; } }
    __syncthreads();
}

__device__ __forceinline__ void router_block(const bf16_t* h2, const bf16_t* wrh, LAS unsigned char* lds, const float* b_router, const float* b_group, const int tb,
                                             int* tok_e, float* tok_g, float* tok_inv, int* hist, LAS int* lhist, const int tid) {
    const int wave = __builtin_amdgcn_readfirstlane(tid >> 6), lane = tid & 63, r32 = lane & 31, hi = lane >> 5;
    if (tid < 32) lhist[tid] = 0;
    constexpr int RPB = 144, XTB = 32 * RPB, WTB = 64 * RPB;
    LAS unsigned char* XH = lds + wave * (2 * XTB); LAS unsigned char* XL = XH + XTB;
    LAS unsigned char* WT = lds + 8 * (2 * XTB);
    LAS float* SSX = (LAS float*)(WT + 4 * WTB) + wave * 32;
    for (int i = tid; i < 4 * WTB / 16; i += 512) *(LAS u32x4*)(WT + 16 * i) = (u32x4){0u, 0u, 0u, 0u};
    __syncthreads();
    const int tok0 = tb * 256 + wave * 32, tok = tok0 + r32;
    const bf16_t* xg = h2 + (size_t)(tok0 + (lane >> 4)) * 1024 + 4 * (lane & 15);
    const int wp0 = tid, wp1 = 512 + tid;
    u32x2 xr[4][8]; u32x4 wq0[4], wq1[4]; float sq[8];
#pragma unroll
    for (int i = 0; i < 8; ++i) sq[i] = 0.f;
#define RT_WSRC(p_, c_) (wrh + (size_t)((p_) / 288) * (36 * 1024) + (size_t)(((p_) % 288) >> 3) * 1024 + 64 * (c_) + 8 * ((p_) & 7))
#define RT_WDST(p_, b_) (WT + (b_) * (2 * WTB) + ((p_) / 288) * WTB + (((p_) % 288) >> 3) * RPB + 16 * ((p_) & 7))
#define RT_LOAD(k_, c_) do { _Pragma("unroll") for (int i_ = 0; i_ < 8; ++i_) xr[k_][i_] = *(const u32x2*)(xg + (size_t)(4 * i_) * 1024 + 64 * (c_)); \
        wq0[k_] = *(const u32x4*)RT_WSRC(wp0, c_); if (wp1 < 576) wq1[k_] = *(const u32x4*)RT_WSRC(wp1, c_); } while (0)
#define RT_STORE(k_, b_) do { _Pragma("unroll") for (int i_ = 0; i_ < 8; ++i_) { const u32x2 h_ = xr[k_][i_]; const f32x4 v_ = (f32x4){bf_lo(h_.x), bf_hi(h_.x), bf_lo(h_.y), bf_hi(h_.y)}; \
            sq[i_] += (v_.x * v_.x + v_.y * v_.y) + (v_.z * v_.z + v_.w * v_.w); \
            const int off_ = (4 * i_ + (lane >> 4)) * RPB + 8 * (lane & 15); *(LAS u32x2*)(XH + off_) = h_; } \
        *(LAS u32x4*)RT_WDST(wp0, b_) = wq0[k_]; if (wp1 < 576) *(LAS u32x4*)RT_WDST(wp1, b_) = wq1[k_]; } while (0)
    f32x16 acc, acc2;
#pragma unroll
    for (int r = 0; r < 16; ++r) { acc[r] = 0.f; acc2[r] = 0.f; }
#pragma unroll 1
    for (int c4 = 0; c4 < 16; c4 += 4) {
#pragma unroll
      for (int k = 0; k < 4; ++k) RT_LOAD(k, c4 + k);
#pragma unroll
      for (int k = 0; k < 4; ++k) { const int c = c4 + k;
        RT_STORE(k, k & 1);
        __syncthreads();
        const LAS unsigned char* xh = XH + r32 * RPB + 16 * hi;
        const LAS unsigned char* wh = WT + (c & 1) * (2 * WTB) + r32 * RPB + 16 * hi; const LAS unsigned char* wl = wh + WTB;
#pragma unroll
        for (int ks = 0; ks < 4; ++ks) {
            const bf16x8 bxh = *(const LAS bf16x8*)(xh + 32 * ks);
            const bf16x8 a1h = *(const LAS bf16x8*)(wh + 32 * ks), a1l = *(const LAS bf16x8*)(wl + 32 * ks);
            const bf16x8 a2h = *(const LAS bf16x8*)(wh + 32 * RPB + 32 * ks), a2l = *(const LAS bf16x8*)(wl + 32 * RPB + 32 * ks);
            acc = __builtin_amdgcn_mfma_f32_32x32x16_bf16(a1l, bxh, acc, 0, 0, 0); acc = __builtin_amdgcn_mfma_f32_32x32x16_bf16(a1h, bxh, acc, 0, 0, 0);
            acc2 = __builtin_amdgcn_mfma_f32_32x32x16_bf16(a2l, bxh, acc2, 0, 0, 0); acc2 = __builtin_amdgcn_mfma_f32_32x32x16_bf16(a2h, bxh, acc2, 0, 0, 0);
        }
      }
    }
#undef RT_LOAD
#undef RT_STORE
#undef RT_WSRC
#undef RT_WDST
#pragma unroll
    for (int i = 0; i < 8; ++i) { float v = sq[i];
        v += __builtin_bit_cast(float, __builtin_amdgcn_update_dpp(0, __builtin_bit_cast(int, v), 0x128, 0xf, 0xf, false));
        v += __builtin_bit_cast(float, __builtin_amdgcn_update_dpp(0, __builtin_bit_cast(int, v), 0x124, 0xf, 0xf, false));
        v += __builtin_bit_cast(float, __builtin_amdgcn_update_dpp(0, __builtin_bit_cast(int, v), 0x122, 0xf, 0xf, false));
        v += __builtin_bit_cast(float, __builtin_amdgcn_update_dpp(0, __builtin_bit_cast(int, v), 0x121, 0xf, 0xf, false));
        if ((lane & 15) == 0) SSX[4 * i + (lane >> 4)] = v; }
    __syncthreads();
    const float ss = SSX[r32];
    float gl[4];
#pragma unroll
    for (int g = 0; g < 4; ++g) gl[g] = hi ? 0.f : acc2[g];
    const float inv = rsqrtf(ss * (1.f / 1024.f) + EPS);
    float gmax = -INFINITY; int gi = 0;
#pragma unroll
    for (int g = 0; g < 4; ++g) { gl[g] = (gl[g] + __shfl_xor(gl[g], 32)) * inv + b_group[g]; if (gl[g] > gmax) { gmax = gl[g]; gi = g; } }
    float gz = 0.f;
#pragma unroll
    for (int g = 0; g < 4; ++g) gz += __expf(gl[g] - gmax);
    const float pg = 1.f / gz;
    float lv[4];
#pragma unroll
    for (int i = 0; i < 4; ++i) { float t = acc[i]; t = (gi == 1) ? acc[4 + i] : t; t = (gi == 2) ? acc[8 + i] : t; t = (gi == 3) ? acc[12 + i] : t;
        lv[i] = t * inv + b_router[8 * gi + 4 * hi + i]; }
    float e8[8];
#pragma unroll
    for (int i = 0; i < 4; ++i) { const float other = __shfl_xor(lv[i], 32); e8[i] = hi ? other : lv[i]; e8[4 + i] = hi ? lv[i] : other; }
    int i0 = 0; float l0 = e8[0];
#pragma unroll
    for (int i = 1; i < 8; ++i) if (e8[i] > l0) { l0 = e8[i]; i0 = i; }
    int i1 = -1; float l1 = -INFINITY;
#pragma unroll
    for (int i = 0; i < 8; ++i) if (i != i0 && e8[i] > l1) { l1 = e8[i]; i1 = i; }
    const float ex1 = __expf(l1 - l0), den = 1.f / (1.f + ex1);
    const int E0 = 8 * gi + i0, E1 = 8 * gi + i1;
    if (hi == 0) { tok_e[tok] = E0 | (E1 << 8); tok_g[2 * tok] = pg * den; tok_g[2 * tok + 1] = pg * ex1 * den; tok_inv[tok] = inv;
        atomicAdd((int*)(lhist + E0), 1); atomicAdd((int*)(lhist + E1), 1); }
    __syncthreads();
    if (tid < 32) hist[tb * 32 + tid] = lhist[tid];
    __syncthreads();
}

__device__ __forceinline__ int opaque_tid() { int t = threadIdx.x; asm volatile("" : "+v"(t)); return t; }
#define PHASE_IDS() const int tid = opaque_tid(); const int lane = tid & 63; const int wave = __builtin_amdgcn_readfirstlane(tid >> 6); (void)lane; (void)wave; DECL_PTRS()
enum { PH_PRO = 0, PH_PROJ, PH_MIX, PH_BRANCH, PH_OUT, PH_CQ, PH_CROSS, PH_CO, PH_ROUTE, PH_SLOT, PH_UP, PH_DOWN, PH_FINAL, N_PHASES };

struct Args { const float* in[28]; float* out; unsigned char* ws; int ph_lo, ph_hi; };

__global__ void __launch_bounds__(512, 2) fwd_kernel(Args args) {
    extern __shared__ __attribute__((aligned(16))) unsigned char lds_raw[];
    LAS unsigned char* lds = (LAS unsigned char*)lds_raw;
    const int tid = threadIdx.x, lane = tid & 63, wave = __builtin_amdgcn_readfirstlane(tid >> 6);
    const int G = gridDim.x, bx = blockIdx.x;
    unsigned char* ws = args.ws;
    volatile LAS unsigned* MISC = (volatile LAS unsigned*)(lds + MISC_OFF);
    LAS int* tab = (LAS int*)(lds + TAB_OFF);
    if (tid < 64) MISC[tid] = 0u;
    __syncthreads();
    const int lo = args.ph_lo, hi_ph = args.ph_hi;
    XcdBarrier bar; bar.bar = (unsigned*)(ws + WS_CTL) + CW_BAR; bar.x = 0; bar.st = MISC + 8;
    if (hi_ph - lo > 1) bar = xcd_barrier_post((unsigned*)(ws + WS_CTL) + CW_BAR, MISC + 8);
#define IN(k) (lo <= (k) && (k) < hi_ph)
#define SEAM(k) do { if (IN(k) && IN((k) + 1)) xcd_barrier(bar); } while (0)

#define KA_(T, off) (*(T const __attribute__((address_space(4)))*)(kp_ + (off)))
#define DECL_PTRS() const __attribute__((address_space(4))) char* kp_ = (const __attribute__((address_space(4))) char*)__builtin_amdgcn_kernarg_segment_ptr(); asm volatile("" : "+s"(kp_)); \
    const float* x = KA_(const float*, 8 * 0); const float* mem = KA_(const float*, 8 * 1); const float* mix_norm = KA_(const float*, 8 * 2); const float* w_in = KA_(const float*, 8 * 3); const float* lam_q1 = KA_(const float*, 8 * 4); const float* lam_k1 = KA_(const float*, 8 * 5); const float* lam_q2 = KA_(const float*, 8 * 6); const float* lam_k2 = KA_(const float*, 8 * 7); const float* diff_subln = KA_(const float*, 8 * 8); const float* w_branch_a = KA_(const float*, 8 * 9); const float* w_branch_b = KA_(const float*, 8 * 10); const float* w_gate = KA_(const float*, 8 * 11); const float* b_gate = KA_(const float*, 8 * 12); const float* w_out = KA_(const float*, 8 * 13); const float* cross_norm = KA_(const float*, 8 * 14); const float* mem_norm = KA_(const float*, 8 * 15); const float* w_cq = KA_(const float*, 8 * 16); const float* w_ckv = KA_(const float*, 8 * 17); const float* w_co = KA_(const float*, 8 * 18); const float* ffn_norm = KA_(const float*, 8 * 19); const float* w_group = KA_(const float*, 8 * 20); const float* b_group = KA_(const float*, 8 * 21); const float* w_router = KA_(const float*, 8 * 22); const float* b_router = KA_(const float*, 8 * 23); const float* w1 = KA_(const float*, 8 * 24); const float* w3 = KA_(const float*, 8 * 25); const float* w2 = KA_(const float*, 8 * 26); const float* final_norm = KA_(const float*, 8 * 27); float* out = KA_(float*, 224); unsigned char* ws = KA_(unsigned char*, 232); float* rowss = (float*)(ws + WS_ROWSS); int* tok_e = (int*)(ws + WS_TOKE); float* tok_g = (float*)(ws + WS_TOKG); int* hist = (int*)(ws + WS_HIST); bf16_t* wrh = (bf16_t*)(ws + WS_WRT); int* sdest = (int*)(ws + WS_SDEST); float* sgate = (float*)(ws + WS_SGATE); int* stok = (int*)(ws + WS_STOK); float* tok_inv = (float*)(ws + WS_TOKINV); float* siv = (float*)(ws + WS_SIV); unsigned char* W8 = ws + WS_WCAT; bf16_t* Wi = (bf16_t*)(ws + WS_WCAT + 5 * MiB); unsigned char* Wa = ws + WS_WA; unsigned char* Wb = ws + WS_WB; unsigned char* Wout = ws + WS_WOUT; unsigned char* Wcq = ws + WS_WCQ; unsigned char* Wckv = ws + WS_WCKV;  unsigned char* Wco = ws + WS_WCO; unsigned char* W13 = ws + WS_W13; unsigned char* W2 = ws + WS_W2; unsigned char* memn8 = ws + WS_MEMN; bf16_t* kvc = (bf16_t*)(ws + WS_KVC); bf16_t* xn = (bf16_t*)(ws + WS_R1); bf16_t* merged = xn; unsigned char* xn2_8 = ws + WS_R1; unsigned char* merged8 = ws + WS_R2; unsigned char* xn8 = ws + WS_R4; unsigned char* hb3 = ws + WS_R1; bf16_t* proj = (bf16_t*)(ws + WS_R2); bf16_t* qc = proj; unsigned char* oc = ws + WS_R2 + (size_t)NTOK * 1024 * 2; bf16_t* xs = proj; unsigned char* gates = ws + WS_R3; unsigned char* y2 = ws + WS_R3; unsigned char* ya = ws + WS_R4; unsigned char* yb = ya + 512; unsigned char* hmid = ws + WS_R4; bf16_t* h1b = (bf16_t*)out; bf16_t* h2b = (bf16_t*)(ws + WS_R2 + 192 * MiB); \
    (void)x; (void)mem; (void)mix_norm; (void)w_in; (void)lam_q1; (void)lam_k1; (void)lam_q2; (void)lam_k2; (void)diff_subln; (void)w_branch_a; (void)w_branch_b; (void)w_gate; (void)b_gate; (void)w_out; \
    (void)cross_norm; (void)mem_norm; (void)w_cq; (void)w_ckv; (void)w_co; (void)ffn_norm; (void)w_group; (void)b_group; (void)w_router; (void)b_router; (void)w1; (void)w3; (void)w2; (void)final_norm; (void)out; \
    (void)rowss; (void)tok_e; (void)tok_g; (void)hist; (void)wrh; (void)sdest; (void)sgate; (void)W8; (void)Wi; (void)Wa; (void)Wb; (void)Wout; (void)Wcq; (void)Wckv; (void)Wco; (void)W13; (void)W2; (void)memn8; (void)merged8; (void)xn8; (void)xn2_8; (void)kvc; \
    (void)stok; (void)tok_inv; (void)siv; (void)hb3; (void)xn; (void)merged; (void)proj; (void)qc; (void)oc; (void)xs; (void)gates; (void)y2; (void)ya; (void)yb; (void)hmid; (void)h1b; (void)h2b; (void)ws

    if (IN(PH_PRO)) for (int rep_ = 0; rep_ < REPS(PH_PRO); ++rep_) { PHASE_IDS();
        LAS float* scr = (LAS float*)(lds + wave * 8704);
        const int gw = bx * 8 + wave, NGW = G * 8;
        constexpr int I0 = 16 * 72, I0C = 16 * 16, I1 = 16 * 64, I2 = 8 * 32, I4 = 16 * 32, I6 = 16 * 64, IE = 256;
        constexpr int NITEMS = I0 + I0C + I1 + 2 * I2 + 3 * I4 + I6 + 3 * 32 * IE;
        for (int it = gw; it < NITEMS; it += NGW) {
            int r = it;
            if (r < I0) { const int kb = r / 72, nb = r % 72; tr_item8(w_in, 2500, 2176, 32 * nb, 64 * kb, W8 + (size_t)(32 * nb) * 1024, 1024, 32.f, scr, lane); continue; } r -= I0;
            if (r < I0C) { const int kb = r / 16, nb = r % 16; tr_item(w_in, 2500, 2500, C_QI + 32 * nb, 64 * kb, Wi + (size_t)(32 * nb) * 1024, 1024, scr, lane); continue; } r -= I0C;
            if (r < I1) { const int kb = r / 64, nb = r % 64; tr_item8(w_gate, 2048, 2048, 32 * nb, 64 * kb, W8 + (size_t)(2304 + 32 * nb) * 1024, 1024, 32.f, scr, lane); continue; } r -= I1;
            if (r < I2) { const int kb = r / 32, nb = r % 32; tr_item8(w_branch_a, 1024, 1024, 32 * nb, 64 * kb, Wa + (size_t)(32 * nb) * 1024, 1024, 16.f, scr, lane); continue; } r -= I2;
            if (r < I2) { const int kb = r / 32, nb = r % 32; tr_item8(w_branch_b, 1024, 1024, 32 * nb, 64 * kb, Wa + 512 + (size_t)(32 * nb) * 1024, 1024, 16.f, scr, lane); continue; } r -= I2;
            if (r < I4) { const int kb = r / 32, nb = r % 32; tr_item8(w_out, 1024, 1024, 32 * nb, 64 * kb, Wout + (size_t)(32 * nb) * 1024, 1024, 32.f, scr, lane); continue; } r -= I4;
            if (r < I4) { const int kb = r / 32, nb = r % 32; tr_item8(w_cq, 1024, 1024, 32 * nb, 64 * kb, Wcq + (size_t)(32 * nb) * 1024, 1024, 32.f, scr, lane); continue; } r -= I4;
            if (r < I6) { const int kb = r / 64, nb = r % 64; tr_item8(w_ckv, 2048, 2048, 32 * nb, 64 * kb, Wckv + (size_t)(32 * nb) * 1024, 1024, 32.f, scr, lane); continue; } r -= I6;
            if (r < I4) { const int kb = r / 32, nb = r % 32; tr_item8(w_co, 1024, 1024, 32 * nb, 64 * kb, Wco + (size_t)(32 * nb) * 1024, 1024, 32.f, scr, lane); continue; } r -= I4;
            if (r < 32 * IE) { const int e = r / IE, q = r % IE, kb = q / 16, nb = q % 16, n0 = 32 * nb;
                tr_item8(w1 + (size_t)e * 1024 * 512, 512, 512, n0, 64 * kb, W13 + ((size_t)e * 1024 + 256 * (n0 >> 7) + (n0 & 127)) * 1024, 1024, 32.f, scr, lane); continue; } r -= 32 * IE;
            if (r < 32 * IE) { const int e = r / IE, q = r % IE, kb = q / 16, nb = q % 16, n0 = 32 * nb;
                tr_item8(w3 + (size_t)e * 1024 * 512, 512, 512, n0, 64 * kb, W13 + ((size_t)e * 1024 + 256 * (n0 >> 7) + 128 + (n0 & 127)) * 1024, 1024, 32.f, scr, lane); continue; } r -= 32 * IE;
            { const int e = r / IE, q = r % IE, kb = q / 32, nb = q % 32;
                tr_item8(w2 + (size_t)e * 512 * 1024, 1024, 1024, 32 * nb, 64 * kb, W2 + ((size_t)e * 1024 + 32 * nb) * 512, 512, 32.f, scr, lane); }
        }
        for (int m = 4 * gw; m < NTOK; m += 4 * NGW) rms_rows4_fp8<true>(x + (size_t)m * 1024, 1024, mix_norm, xn8 + (size_t)m * 1024, xn + (size_t)m * 1024, lane);
        for (int m = 4 * gw; m < NB * NMEM; m += 4 * NGW) rms_rows4_fp8<false>(mem + (size_t)m * 1024, 1024, mem_norm, memn8 + (size_t)m * 1024, (bf16_t*)nullptr, lane);
        for (int i = bx * 512 + tid; i < NTOK; i += G * 512) rowss[i] = 0.f;
        for (int i = bx * 512 + tid; i < 36 * 1024; i += G * 512) { const int j = i >> 10, k = i & 1023;
            const float w = ffn_norm[k] * (j < 32 ? w_router[k * 32 + j] : w_group[k * 4 + (j - 32)]);
            const unsigned hb = cvt_pk_bf16(w, 0.f) & 0xffffu; const float wl = w - bf_lo(hb);
            wrh[i] = (bf16_t)hb; wrh[36 * 1024 + i] = (bf16_t)(cvt_pk_bf16(wl, 0.f) & 0xffffu); }
    }
    SEAM(PH_PRO);

    if (IN(PH_PROJ)) for (int rep_ = 0; rep_ < REPS(PH_PROJ); ++rep_) { PHASE_IDS();
        LAS float* bgl = (LAS float*)(lds + 131072);
        for (int i = tid; i < 2048; i += 512) bgl[i] = b_gate[i];
        { pg8::Gemm g{(const bf16_t*)xn8, (const bf16_t*)W8, 1024}; pg8::StaticOrder S; S.init(NTOK, 4352, 512, G, bx);
          pg8::EpiProj E{proj, gates, bgl, 0}; pg8::gemm_phase<false, true>(lds, g, S, E); }
        { pg8::Gemm g{xn, Wi, 1024}; pg8::StaticOrder S; S.init(NTOK, 512, 1024, G, bx);
          pg8::EpiProj E{proj, gates, bgl, 1}; pg8::gemm_phase(lds, g, S, E); }
    }
    SEAM(PH_PROJ);

    if (IN(PH_MIX)) { PHASE_IDS();
        float lam;
        { const float a = wave_sum(lam_q1[lane] * lam_k1[lane]), c = wave_sum(lam_q2[lane] * lam_k2[lane]); lam = __expf(a) - __expf(c) + 0.2f; }
        const int vcu = (G % 8 == 0) ? (bx % 8) * (G / 8) + bx / 8 : bx;
        if (tid < 128) ((LAS float*)(lds + 131072))[tid] = diff_subln[tid];
        for (int rep_ = 0; rep_ < REPS(100); ++rep_)
        for (int L = vcu; L < 2048; L += G) { const int i = L >> 8, c = L & 255, grp = c >> 4, k = c & 15, bh = grp * 8 + i;
            const int qb = (i & 1) ? (15 - k) : k;
            diffattn_unit(proj, ya, diff_subln, lam, bh >> 2, bh & 3, qb, lds, tid); }
        for (int rep_ = 0; rep_ < REPS(101); ++rep_)
        for (int L = vcu; L < 2048; L += G) { const int i = L >> 8, c = L & 255, grp = c >> 4, k = c & 15, b = grp * 2 + (i >> 2), ii = i & 3;
            const int qblk = (ii == 0) ? k : (ii == 1) ? (31 - k) : (ii == 2) ? (32 + k) : (63 - k);
            dsa_unit(proj, yb, b, qblk, lds, tid); }
    }
    SEAM(PH_MIX);

    if (IN(PH_BRANCH)) for (int rep_ = 0; rep_ < REPS(PH_BRANCH); ++rep_) { PHASE_IDS();
        pg8::Gemm g{(const bf16_t*)ya, (const bf16_t*)Wa, 1024}; pg8::StaticOrder S; S.init(NTOK, 1024, 512, G, bx); pg8::EpiBranchF E{gates, merged8}; pg8::gemm_phase<false, true>(lds, g, S, E);
    }
    SEAM(PH_BRANCH);

    if (IN(PH_OUT)) for (int rep_ = 0; rep_ < REPS(PH_OUT); ++rep_) { PHASE_IDS();
        { pg8::Gemm g{(const bf16_t*)merged8, (const bf16_t*)Wout, 1024}; pg8::StaticOrder S; S.init(NTOK, 1024, 512, G, bx); pg8::EpiResidSq E{x, h1b, xn2_8, cross_norm, rowss, 1.f / 256.f}; pg8::gemm_phase<false, true>(lds, g, S, E); }
        { pg8::Gemm g{(const bf16_t*)memn8, (const bf16_t*)Wckv, 1024}; pg8::StaticOrder S; S.init(NB * NMEM, 2048, 512, G, bx); pg8::EpiPlain E{kvc, 2048, 1.f / 32.f}; pg8::gemm_phase<false, true>(lds, g, S, E); }
    }
    SEAM(PH_OUT);

    if (IN(PH_CQ)) for (int rep_ = 0; rep_ < REPS(PH_CQ); ++rep_) { PHASE_IDS();
        pg8::Gemm g{(const bf16_t*)xn2_8, (const bf16_t*)Wcq, 1024}; pg8::StaticOrder S; S.init(NTOK, 1024, 512, G, bx); pg8::EpiRowScale E{qc, 1024, rowss, 1.f / 32.f}; pg8::gemm_phase<false, true>(lds, g, S, E);
    }
    SEAM(PH_CQ);

    if (IN(PH_CROSS)) for (int rep_ = 0; rep_ < REPS(PH_CROSS); ++rep_) { PHASE_IDS();
        const int vcu = (G % 8 == 0) ? (bx % 8) * (G / 8) + bx / 8 : bx;
        for (int L = vcu; L < 2048; L += G) { const int i = L >> 8, c = L & 255, bhx = (c >> 4) * 8 + i; cross_unit(qc, kvc, oc, bhx >> 2, bhx & 3, c & 15, lds, tid); }
    }
    SEAM(PH_CROSS);

    if (IN(PH_CO)) { PHASE_IDS();
        pg8::Gemm g{(const bf16_t*)oc, (const bf16_t*)Wco, 1024}; pg8::StaticOrder S; S.init(NTOK, 1024, 512, G, bx); pg8::EpiResidHb E{h1b, h2b, hb3, ffn_norm, 1.f / 512.f}; pg8::gemm_phase<false, true>(lds, g, S, E);
    }
    SEAM(PH_CO);

    if (IN(PH_ROUTE)) for (int rep_ = 0; rep_ < REPS(PH_ROUTE); ++rep_) { PHASE_IDS();
        for (int tb = bx; tb < 256; tb += G) router_block(h2b, wrh, lds, b_router, b_group, tb, tok_e, tok_g, tok_inv, hist, tab, tid);
    }
    SEAM(PH_ROUTE);

    if (IN(PH_SLOT)) for (int rep_ = 0; rep_ < REPS(PH_SLOT); ++rep_) { PHASE_IDS();
        for (int tb = bx; tb < 256; tb += G) {
            moe_tables(hist, tab, tb, tid);
            LAS int* wcnt = tab + 700;
            int E0 = 0, E1 = 0, r0 = 0, r1 = 0;
            if (tid < 256) {
                const int pe = tok_e[tb * 256 + tid]; E0 = pe & 255; E1 = pe >> 8;
                const unsigned long long lt = (1ull << lane) - 1ull;
                for (int e = 0; e < 32; ++e) { const unsigned long long mk = __ballot((E0 == e) || (E1 == e));
                    const int rk = __popcll(mk & lt);
                    if (E0 == e) r0 = rk; if (E1 == e) r1 = rk;
                    if (lane == 0) wcnt[wave * 32 + e] = __popcll(mk); }
            }
            __syncthreads();
            if (tid < 256) {
                int o0 = 0, o1 = 0;
                for (int w = 0; w < wave; ++w) { o0 += wcnt[w * 32 + E0]; o1 += wcnt[w * 32 + E1]; }
                const int s0 = tab[32 + E0] + tab[640 + E0] + o0 + r0, s1 = tab[32 + E1] + tab[640 + E1] + o1 + r1;
                const int tok = tb * 256 + tid;
                sdest[s0] = 2 * tok; sdest[s1] = 2 * tok + 1; sgate[s0] = tok_g[2 * tok]; sgate[s1] = tok_g[2 * tok + 1]; stok[s0] = tok; stok[s1] = tok; { const float iv = tok_inv[tok] * (1.f / 32.f); siv[s0] = iv; siv[s1] = iv; }
            }
            if (tb == 0) {
                for (int e = wave; e < 32; e += 8) { const int cnt = tab[e], st = tab[32 + e], pend = ((cnt + 255) >> 8) << 8;
                    for (int s = cnt + lane; s < pend; s += 64) { sdest[st + s] = -1; sgate[st + s] = 0.f; stok[st + s] = 0; siv[st + s] = 0.f; } }
            }
            __syncthreads();
        }
    }
    SEAM(PH_SLOT);

    if (IN(PH_UP)) for (int rep_ = 0; rep_ < REPS(PH_UP); ++rep_) { PHASE_IDS();
        moe_tables(hist, tab, 0, tid);
        pg8::Gemm g{(const bf16_t*)hb3, (const bf16_t*)W13, 1024};
        pg8::MoeOrder S; S.G = G; S.c = bx; S.n_units = tab[108] * 4; S.rb2e = (const LAS unsigned char*)(tab + 1600); S.ridx = stok;
        S.a_step = 0; S.b_estep = (size_t)1024 * 1024; S.b_tstep = (size_t)256 * 1024;
        pg8::EpiSwiGLU E{hmid, sgate, siv};
        pg8::gemm_phase<true, true>(lds, g, S, E);
    }
    SEAM(PH_UP);

    if (IN(PH_DOWN)) for (int rep_ = 0; rep_ < REPS(PH_DOWN); ++rep_) { PHASE_IDS();
        moe_tables(hist, tab, 0, tid);
        pg8::Gemm g{(const bf16_t*)hmid, (const bf16_t*)W2, 512};
        pg8::MoeOrder S; S.G = G; S.c = bx; S.n_units = tab[108] * 4; S.rb2e = (const LAS unsigned char*)(tab + 1600);
        S.a_step = (size_t)256 * 512; S.b_estep = (size_t)1024 * 512; S.b_tstep = (size_t)256 * 512; S.ridx = nullptr;
        pg8::EpiDown E{y2, sdest};
        pg8::gemm_phase<false, true>(lds, g, S, E);
    }
    SEAM(PH_DOWN);

    if (IN(PH_FINAL)) { PHASE_IDS();
        const int gw = bx * 8 + wave, NGW = G * 8;
        for (int m = gw; m < NTOK; m += NGW) {
            f32x4* xr = (f32x4*)(out + (size_t)m * 1024) + lane; const f32x4* gr = (const f32x4*)final_norm + lane; const u32x2* hr = (const u32x2*)(h2b + (size_t)m * 1024) + lane;
            const unsigned* ya_ = (const unsigned*)(y2 + (size_t)(2 * m) * 1024) + lane; const unsigned* yb_ = (const unsigned*)(y2 + (size_t)(2 * m + 1) * 1024) + lane;
            f32x4 v[4]; float s = 0.f;
#pragma unroll
            for (int j = 0; j < 4; ++j) { const u32x2 hw = hr[64 * j]; v[j] = (f32x4){bf_lo(hw.x), bf_hi(hw.x), bf_lo(hw.y), bf_hi(hw.y)}; const int a = (int)ya_[64 * j], c = (int)yb_[64 * j];
                const f32x2 a0 = __builtin_amdgcn_cvt_pk_f32_fp8(a, false), a1 = __builtin_amdgcn_cvt_pk_f32_fp8(a, true), c0 = __builtin_amdgcn_cvt_pk_f32_fp8(c, false), c1 = __builtin_amdgcn_cvt_pk_f32_fp8(c, true);
                v[j].x += (a0.x + c0.x) * (1.f / 16.f); v[j].y += (a0.y + c0.y) * (1.f / 16.f); v[j].z += (a1.x + c1.x) * (1.f / 16.f); v[j].w += (a1.y + c1.y) * (1.f / 16.f);
                s += (v[j].x * v[j].x + v[j].y * v[j].y) + (v[j].z * v[j].z + v[j].w * v[j].w); }
            const float r = rsqrtf(wave_sum(s) * (1.f / 1024.f) + EPS);
#pragma unroll
            for (int j = 0; j < 4; ++j) { const f32x4 gv = gr[64 * j]; xr[64 * j] = (f32x4){v[j].x * r * gv.x, v[j].y * r * gv.y, v[j].z * r * gv.z, v[j].w * r * gv.w}; }
        }
    }
#undef IN
#undef SEAM
}

extern "C" void kernel_launch(void* const* d_in, const int* in_sizes, int n_in, void* d_out, int out_size, void* d_ws, size_t ws_size, hipStream_t stream) {
    static int grid = 0;
    if (grid == 0) {
        if (n_in != 28 || out_size != NTOK * DM || ws_size < WS_END) { fprintf(stderr, "kernel_launch: unexpected shapes (n_in %d out %d ws %zu)\n", n_in, out_size, ws_size); grid = -1; return; }
        int dev = 0, cus = 0, per_cu = 0;
        if (hipGetDevice(&dev) != hipSuccess || hipDeviceGetAttribute(&cus, hipDeviceAttributeMultiprocessorCount, dev) != hipSuccess) { grid = -1; return; }
        if (hipFuncSetAttribute((const void*)fwd_kernel, hipFuncAttributeMaxDynamicSharedMemorySize, LDS_BYTES) != hipSuccess) { fprintf(stderr, "kernel_launch: hipFuncSetAttribute failed\n"); grid = -1; return; }
        if (hipOccupancyMaxActiveBlocksPerMultiprocessor(&per_cu, (const void*)fwd_kernel, 512, LDS_BYTES) != hipSuccess || per_cu < 1) { fprintf(stderr, "kernel_launch: occupancy query says %d\n", per_cu); }
        (void)hipGetLastError();
        grid = cus;
    }
    if (grid < 0) return;
    hipMemsetAsync((char*)d_ws + WS_CTL, 0, CTL_ZERO_BYTES, stream);
    Args a{};
    for (int i = 0; i < 28; ++i) a.in[i] = (const float*)d_in[i];
    a.out = (float*)d_out; a.ws = (unsigned char*)d_ws;
#if N_LAUNCH_SPLIT
    for (int p = 0; p < N_PHASES; ++p) { a.ph_lo = p; a.ph_hi = p + 1; hipLaunchKernelGGL(fwd_kernel, dim3(grid), dim3(512), LDS_BYTES, stream, a); }
#else
    a.ph_lo = 0; a.ph_hi = N_PHASES; hipLaunchKernelGGL(fwd_kernel, dim3(grid), dim3(512), LDS_BYTES, stream, a);
#endif
}
```

```cpp
#include <hip/hip_runtime.h>
#include <cstdio>
#include <cstdint>

#ifndef N_LAUNCH_SPLIT
#define N_LAUNCH_SPLIT 0
#endif

#ifndef REP_PHASE
#define REP_PHASE (-1)
#endif
#define REPS(k) ((REP_PHASE == (k)) ? 2 : 1)
#define LAS __attribute__((address_space(3)))
#define GAS __attribute__((address_space(1)))
typedef unsigned short bf16_t;
typedef short bf16x8 __attribute__((ext_vector_type(8)));
typedef short s16x4 __attribute__((ext_vector_type(4)));
typedef float f32x2 __attribute__((ext_vector_type(2)));
typedef float f32x4 __attribute__((ext_vector_type(4)));
typedef float f32x16 __attribute__((ext_vector_type(16)));
typedef unsigned u32x2 __attribute__((ext_vector_type(2)));
typedef unsigned u32x4 __attribute__((ext_vector_type(4)));
typedef __bf16 bf16x2_t __attribute__((ext_vector_type(2)));
typedef int v4i32 __attribute__((ext_vector_type(4)));
typedef int v8i32 __attribute__((ext_vector_type(8)));

constexpr int NB = 32, SEQ = 2048, DM = 1024, NTOK = NB * SEQ, NMEM = 256;
constexpr int PW = 2560;
constexpr int C_QA = 0, C_KA = 512, C_VA = 1024, C_QB = 1536, C_KB = 2048, C_VB = 2112, C_QI = 2176, C_KI = 2432, C_WI = 2496;
constexpr int NEXP = 32, DEXP = 512;
constexpr int MAXSLOT = 2 * NTOK + NEXP * 256;
constexpr float EPS = 1e-6f, LOG2E = 1.4426950408889634f;

constexpr size_t MiB = 1u << 20;
constexpr size_t WS_CTL = 0, CTL_ZERO_BYTES = 64 * 1024;
constexpr size_t WS_ROWSS = 512 * 1024;
constexpr size_t WS_TOKE = 1 * MiB;
constexpr size_t WS_TOKG = WS_TOKE + 256 * 1024;
constexpr size_t WS_TOKINV = WS_TOKG + 512 * 1024;
constexpr size_t WS_HIST = 2 * MiB;
constexpr size_t WS_WRT  = WS_HIST + 32 * 1024;
constexpr size_t WS_SDEST = 2 * MiB + 256 * 1024;
constexpr size_t WS_STOK  = WS_SDEST + 576 * 1024;
constexpr size_t WS_SGATE = WS_STOK + 576 * 1024;
static_assert(WS_WRT + 36 * 1024 * 4 <= WS_SDEST && WS_SGATE + (size_t)MAXSLOT * 4 <= 4 * MiB && (size_t)MAXSLOT * 4 <= 576 * 1024, "small arrays");
constexpr size_t WS_WCAT = 4 * MiB;
constexpr size_t WS_WA = 13 * MiB, WS_WB = 14 * MiB, WS_WOUT = 15 * MiB, WS_WCQ = 17 * MiB, WS_WCKV = 19 * MiB, WS_WCO = 23 * MiB;
constexpr size_t WS_W13 = 25 * MiB;
constexpr size_t WS_W2 = 89 * MiB;
constexpr size_t WS_MEMN = 121 * MiB;
constexpr size_t WS_KMSQ = 40 * 1024;
constexpr size_t WS_KVC = 137 * MiB;
constexpr size_t WS_R1 = 176 * MiB;
constexpr size_t WS_R2 = 304 * MiB;
constexpr size_t WS_R3 = 624 * MiB;
constexpr size_t WS_R4 = 880 * MiB;
constexpr size_t WS_SIV = 1016 * MiB;
constexpr size_t WS_END = 1017 * MiB;
static_assert(WS_R4 + (size_t)MAXSLOT * DEXP * 2 <= WS_SIV && WS_SIV + (size_t)MAXSLOT * 4 <= WS_END, "ws map");
static_assert(WS_R2 + (size_t)MAXSLOT * DM * 2 <= WS_R3, "ws map");
constexpr int CW_BAR = 1024;

constexpr int SCR_BYTES = 135424;
constexpr int ISC_PITCH = 4232;
constexpr int MASK_OFF = SCR_BYTES, MASK_PITCH_W = 66;
constexpr int TAB_OFF = MASK_OFF + 32 * MASK_PITCH_W * 4;
constexpr int TAB_BYTES = 8192;
constexpr int QIDX_OFF = TAB_OFF;
constexpr int MISC_OFF = 163840 - 256;
constexpr int LDS_BYTES = MISC_OFF + 256;
static_assert(TAB_OFF % 16 == 0 && MISC_OFF % 16 == 0 && LDS_BYTES <= 163840 && TAB_OFF + TAB_BYTES <= MISC_OFF && QIDX_OFF + 32 * 528 <= MISC_OFF, "lds map");

__device__ __forceinline__ unsigned cvt_pk_bf16(float lo, float hi) { f32x2 v = {lo, hi}; bf16x2_t b = __builtin_convertvector(v, bf16x2_t); return __builtin_bit_cast(unsigned, b); }
__device__ __forceinline__ unsigned pack4_fp8(float a, float b, float c, float d) { int w = 0; w = __builtin_amdgcn_cvt_pk_fp8_f32(a, b, w, false); w = __builtin_amdgcn_cvt_pk_fp8_f32(c, d, w, true); return (unsigned)w; }
__device__ __forceinline__ float bf_lo(unsigned w) { return __uint_as_float(w << 16); }
__device__ __forceinline__ float bf_hi(unsigned w) { return __uint_as_float(w & 0xffff0000u); }
__device__ __forceinline__ float bf2f(bf16_t b) { return __uint_as_float((unsigned)b << 16); }
__device__ __forceinline__ float wave_sum(float v) {
#pragma unroll
    for (int o = 1; o < 64; o <<= 1) v += __shfl_xor(v, o);
    return v;
}
__device__ __forceinline__ float xor32_sum(float v) {
    const auto rr = __builtin_amdgcn_permlane32_swap(__float_as_uint(v), __float_as_uint(v), false, false);
    return __uint_as_float(rr[0]) + __uint_as_float(rr[1]);
}
__device__ __forceinline__ float fexp2(float x) { return __builtin_amdgcn_exp2f(x); }
__device__ __forceinline__ float frcp(float x) { return __builtin_amdgcn_rcpf(x); }
__device__ __forceinline__ int crow(int r, int hi) { return (r & 3) + 8 * (r >> 2) + 4 * hi; }
#define LDS_WAIT() asm volatile("s_waitcnt lgkmcnt(0)" ::: "memory")
#define VM_WAIT() asm volatile("s_waitcnt vmcnt(0)" ::: "memory")

namespace pg8 {
constexpr int BM = 256, BK = 64, HALF = 128, HTB = HALF * BK * 2, NXCD = 8, WGM = 8;
__host__ __device__ __forceinline__ int lds_byte(int r, int c) { const int st = (r >> 4) * 2 + (c >> 5), rr = r & 15, cc = c & 31, ob = rr * 64 + cc * 2; return st * 1024 + (ob ^ (((ob >> 9) & 1) << 5)); }
__host__ __device__ __forceinline__ void stage_rc(int b, int& R, int& C) { const int st = b / 1024, sb = b % 1024, swz = sb ^ (((sb >> 9) & 1) << 5); R = (st >> 1) * 16 + swz / 64; C = (st & 1) * 32 + (swz % 64) / 2; }
__host__ __device__ __forceinline__ int perm32(int rho) { const int n = rho >> 4, i = rho & 15; return 8 * (i >> 2) + 4 * n + (i & 3); }

struct Unit { int pm, pn, e; };
struct Gemm { const bf16_t* A; const bf16_t* Bt; int K; };

struct StaticOrder {
    int nM, nN, nwg, G, c; size_t tstep;
    __device__ void init(int M, int N, int K, int G_, int c_) { nM = M / BM; nN = N / BM; nwg = nM * nN; G = G_; c = c_; tstep = (size_t)BM * K * 2; }
    __device__ __forceinline__ bool next(int i, Unit& u) const {
        const long L = (long)i * G + c; if (L >= nwg) return false;
        int wgid = (int)L; { const int q = nwg / NXCD, r = nwg % NXCD, xcd = wgid % NXCD, off = wgid / NXCD; wgid = (xcd < r ? xcd * (q + 1) : r * (q + 1) + (xcd - r) * q) + off; }
        const int nig = WGM * nN, gid = wgid / nig, fm = gid * WGM, gsz = (nM - fm) < WGM ? (nM - fm) : WGM;
        u.pm = fm + ((wgid % nig) % gsz); u.pn = (wgid % nig) / gsz; u.e = 0; return true;
    }
    __device__ __forceinline__ const char* pa(const Gemm& g, const Unit& u) const { return (const char*)g.A + (size_t)u.pm * tstep; }
    __device__ __forceinline__ const char* pb(const Gemm& g, const Unit& u) const { return (const char*)g.Bt + (size_t)u.pn * tstep; }
    __device__ __forceinline__ const int* rowidx() const { return nullptr; }
};
struct PanelOrder {
    int pm, nN; size_t tstep;
    __device__ void init(int pm_, int N, int K) { pm = pm_; nN = N / BM; tstep = (size_t)BM * K * 2; }
    __device__ __forceinline__ bool next(int i, Unit& u) const { if (i >= nN) return false; u.pm = pm; u.pn = i; u.e = 0; return true; }
    __device__ __forceinline__ const char* pa(const Gemm& g, const Unit& u) const { return (const char*)g.A + (size_t)u.pm * tstep; }
    __device__ __forceinline__ const char* pb(const Gemm& g, const Unit& u) const { return (const char*)g.Bt + (size_t)u.pn * tstep; }
    __device__ __forceinline__ const int* rowidx() const { return nullptr; }
};
struct MoeOrder {
    int G, c, n_units; const LAS unsigned char* rb2e; size_t a_step, b_estep, b_tstep; const int* ridx;
    __device__ __forceinline__ const int* rowidx() const { return ridx; }
    __device__ __forceinline__ bool next(int i, Unit& u) const {
        const int L = i * G + c; if (L >= n_units) return false;
        u.pm = L >> 2; u.pn = L & 3; u.e = rb2e[u.pm]; return true;
    }
    __device__ __forceinline__ const char* pa(const Gemm& g, const Unit& u) const { return (const char*)g.A + (size_t)u.pm * a_step; }
    __device__ __forceinline__ const char* pb(const Gemm& g, const Unit& u) const { return (const char*)g.Bt + (size_t)u.e * b_estep + (size_t)u.pn * b_tstep; }
};

template <bool F8> struct FragT;
template <class E> struct EpiBadj { static constexpr bool v = false; };
template <class E> struct EpiMid { static constexpr bool v = false; };
template <> struct FragT<false> {
    struct Fr { bf16x8 k[2]; }; struct A4 { Fr f[4]; }; struct B2 { Fr f[2]; };
    static __device__ __forceinline__ void load(Fr& d, const LAS unsigned char* p) { d.k[0] = *(const LAS bf16x8*)p; d.k[1] = *(const LAS bf16x8*)(p + 1024); }
    static __device__ __forceinline__ void mma(f32x4& c, const Fr& b, const Fr& a) { c = __builtin_amdgcn_mfma_f32_16x16x32_bf16(b.k[0], a.k[0], c, 0, 0, 0); c = __builtin_amdgcn_mfma_f32_16x16x32_bf16(b.k[1], a.k[1], c, 0, 0, 0); }
};
template <> struct FragT<true> {
    struct Fr { v8i32 v; }; struct A4 { Fr f[4]; }; struct B2 { Fr f[2]; };
    static __device__ __forceinline__ void load(Fr& d, const LAS unsigned char* p) { const v4i32 lo = *(const LAS v4i32*)p, hi = *(const LAS v4i32*)(p + 1024); d.v = __builtin_shufflevector(lo, hi, 0, 1, 2, 3, 4, 5, 6, 7); }
    static __device__ __forceinline__ void mma(f32x4& c, const Fr& b, const Fr& a) {
        asm volatile("v_mfma_scale_f32_16x16x128_f8f6f4 %0, %1, %2, %0, %3, %3 op_sel_hi:[0,0,0]" : "+v"(c) : "v"(b.v), "v"(a.v), "v"(0x7f7f7f7f)); }
};
template <bool GATHER = false, bool F8 = false, class Epi, class Sched>
__device__ __forceinline__ void gemm_phase(LAS unsigned char* lds, const Gemm g, const Sched& S, const Epi& E) {
    const int tid = threadIdx.x, wid = __builtin_amdgcn_readfirstlane(tid >> 6), lane = tid & 63, wr = wid >> 2, wc = wid & 3, fr = lane & 15, fq = lane >> 4;
    const int K = F8 ? g.K / 2 : g.K, nt = K / BK;
    unsigned voffB[2]; int RA[2], CA2[2];
    unsigned vA0c[2], vA1c[2], vA0n[2], vA1n[2];
    const size_t kstep = (size_t)(BK * 2);
    const size_t hstep = (size_t)HALF * K * 2;
    constexpr bool BADJ = EpiBadj<Epi>::v;
    const size_t hstepB = BADJ ? (size_t)8 * K * 2 : hstep;
#pragma unroll
    for (int i = 0; i < 2; ++i) { int R, C; stage_rc(tid * 16 + i * 8192, R, C); const int Rb = BADJ ? 64 * (R >> 5) + 16 * ((R & 15) >> 2) + 4 * ((R & 31) >> 4) + (R & 3) : (R & ~31) + perm32(R & 31);
        RA[i] = R; CA2[i] = C * 2; voffB[i] = (unsigned)(Rb * K + C) * 2u;
        vA0c[i] = (unsigned)(R * K + C) * 2u; vA1c[i] = vA0c[i] + (unsigned)hstep; vA0n[i] = vA0c[i]; vA1n[i] = vA1c[i]; }
#define PG8_ROWS(v0, v1, u) do { if (GATHER) { const int* ri_ = S.rowidx() + (size_t)(u).pm * BM; _Pragma("unroll") for (int i_ = 0; i_ < 2; ++i_) { \
        v0[i_] = (unsigned)ri_[RA[i_]] * (unsigned)(K * 2) + (unsigned)CA2[i_]; v1[i_] = (unsigned)ri_[HALF + RA[i_]] * (unsigned)(K * 2) + (unsigned)CA2[i_]; } \
        _Pragma("unroll") for (int i_ = 0; i_ < 2; ++i_) { asm volatile("" : "+v"(v0[i_])); asm volatile("" : "+v"(v1[i_])); } } } while (0)
#define PG8_SEL(n, c) (GATHER ? (last ? (n) : (c)) : (c))
    const unsigned ldsw = (unsigned)wid * 1024u;
    const int aoff = lds_byte(wr * 64 + fr, fq * 8), boff = lds_byte(wc * 32 + fr, fq * 8);
#define PG8_SA(b, h) (((b) * 2 + (h)) * HTB)
#define PG8_SB(b, h) ((4 + (b) * 2 + (h)) * HTB)
#define PG8_STAGE(bufoff, gbase, voff) do { _Pragma("unroll") for (int _i = 0; _i < 2; ++_i) \
        __builtin_amdgcn_global_load_lds((const unsigned*)((const char*)(gbase) + (voff)[_i]), (LAS unsigned*)(lds + (bufoff) + ldsw + _i * 8192), 16, 0, 0); } while (0)
#define PG8_LDA(dst, b, h) do { _Pragma("unroll") for (int m = 0; m < 4; ++m) FragT<F8>::load(dst.f[m], lds + PG8_SA(b, h) + aoff + m * 2048); } while (0)
#define PG8_LDB(dst, b, h) do { _Pragma("unroll") for (int n = 0; n < 2; ++n) FragT<F8>::load(dst.f[n], lds + PG8_SB(b, h) + boff + n * 2048); } while (0)
#define PG8_MMA(ai, bj, At, Bt) do { if constexpr (F8) __builtin_amdgcn_sched_barrier(0); __builtin_amdgcn_s_setprio(1); _Pragma("unroll") for (int m = 0; m < 4; ++m) _Pragma("unroll") for (int n = 0; n < 2; ++n) \
        FragT<F8>::mma(acc[ai][bj][m][n], Bt.f[n], At.f[m]); __builtin_amdgcn_s_setprio(0); if constexpr (F8) __builtin_amdgcn_sched_barrier(0); } while (0)
#define PG8_WAIT_V(n) asm volatile("s_waitcnt vmcnt(" #n ")" ::: "memory")
#define PG8_WAIT_L(n) asm volatile("s_waitcnt lgkmcnt(" #n ")" ::: "memory")
#define PG8_BAR __builtin_amdgcn_s_barrier()
#define PG8_SCHED __builtin_amdgcn_sched_barrier(0)
    Unit cur, nxt; int ui = 0;
    if (!S.next(0, cur)) return;
    f32x4 acc[2][2][4][2];
#pragma unroll
    for (int a = 0; a < 2; ++a)
#pragma unroll
        for (int b = 0; b < 2; ++b)
#pragma unroll
            for (int m = 0; m < 4; ++m)
#pragma unroll
                for (int n = 0; n < 2; ++n) acc[a][b][m][n] = (f32x4){0.f, 0.f, 0.f, 0.f};
    typedef typename FragT<F8>::A4 AFr; typedef typename FragT<F8>::B2 BFr;
    AFr At; BFr B0, B1;
    const char* cA = S.pa(g, cur); const char* cB = S.pb(g, cur);
    PG8_ROWS(vA0c, vA1c, cur);
    PG8_STAGE(PG8_SB(0, 0), cB, voffB); PG8_STAGE(PG8_SB(0, 1), cB + hstepB, voffB); PG8_STAGE(PG8_SA(0, 0), cA, vA0c); PG8_STAGE(PG8_SA(0, 1), cA, vA1c);
    if (wr == 1) PG8_BAR;
    PG8_WAIT_V(2); PG8_BAR;
    PG8_STAGE(PG8_SB(1, 0), cB + kstep, voffB); PG8_STAGE(PG8_SA(1, 0), cA + kstep, vA0c); PG8_STAGE(PG8_SB(1, 1), cB + hstepB + kstep, voffB);
    PG8_WAIT_V(6); PG8_BAR;
    for (;;) {
        const bool has_next = S.next(ui + 1, nxt);
        const char* nA = has_next ? S.pa(g, nxt) : cA; const char* nB = has_next ? S.pb(g, nxt) : cB;
        if (GATHER) { if (has_next) PG8_ROWS(vA0n, vA1n, nxt); else {
#pragma unroll
            for (int i = 0; i < 2; ++i) { vA0n[i] = vA0c[i]; vA1n[i] = vA1c[i]; } } }
#pragma unroll 1
        for (int t = 0; t < nt; t += 2) {
            const bool last = (t == nt - 2);
            const char* a1 = cA + (size_t)(t + 1) * kstep;
            const char* a2 = last ? nA : cA + (size_t)(t + 2) * kstep; const char* b2 = last ? nB : cB + (size_t)(t + 2) * kstep;
            const char* a3 = a2 + kstep; const char* b3 = b2 + kstep;
            unsigned w0[2], w1[2];
#pragma unroll
            for (int i = 0; i < 2; ++i) { w0[i] = PG8_SEL(vA0n[i], vA0c[i]); w1[i] = PG8_SEL(vA1n[i], vA1c[i]); }
            PG8_LDB(B0, 0, 0); PG8_LDB(B1, 0, 1); PG8_SCHED; PG8_LDA(At, 0, 0); PG8_STAGE(PG8_SA(1, 1), a1, vA1c);
            PG8_WAIT_V(8); PG8_WAIT_L(0); PG8_BAR; PG8_MMA(0, 0, At, B0); PG8_MMA(0, 1, At, B1); PG8_BAR; PG8_SCHED;
            PG8_LDA(At, 0, 1); PG8_STAGE(PG8_SB(0, 0), b2, voffB); PG8_STAGE(PG8_SB(0, 1), b2 + hstepB, voffB); PG8_STAGE(PG8_SA(0, 0), a2, w0);
            PG8_WAIT_V(8); PG8_WAIT_L(0); PG8_BAR; PG8_MMA(1, 0, At, B0); PG8_MMA(1, 1, At, B1); PG8_BAR; PG8_SCHED;
            PG8_LDB(B0, 1, 0); PG8_LDB(B1, 1, 1); PG8_SCHED; PG8_LDA(At, 1, 0); PG8_STAGE(PG8_SA(0, 1), a2, w1);
            PG8_WAIT_V(8); PG8_WAIT_L(0); PG8_BAR; PG8_MMA(0, 0, At, B0); PG8_MMA(0, 1, At, B1); PG8_BAR; PG8_SCHED;
            PG8_LDA(At, 1, 1); PG8_STAGE(PG8_SB(1, 0), b3, voffB); PG8_STAGE(PG8_SB(1, 1), b3 + hstepB, voffB); PG8_STAGE(PG8_SA(1, 0), a3, w0);
            PG8_WAIT_V(8); PG8_WAIT_L(0); PG8_BAR; PG8_MMA(1, 0, At, B0); PG8_MMA(1, 1, At, B1); PG8_BAR; PG8_SCHED;
            if constexpr (EpiMid<Epi>::v) { if (t == nt / 2 - 2) {
                if constexpr (F8) asm volatile("s_nop 15\n\ts_nop 15" ::: "memory");
                E.mid(acc, cur, wr, wc, fr, fq);
                if constexpr (F8) asm volatile("s_nop 7" ::: "memory"); PG8_SCHED; } }
        }
        if (wr == 0) PG8_BAR;
        if constexpr (F8) asm volatile("s_nop 15\n\ts_nop 15" ::: "memory");
        E(acc, cur, wr, wc, fr, fq);
        if (!has_next) break;
#pragma unroll
        for (int a = 0; a < 2; ++a)
#pragma unroll
            for (int b = 0; b < 2; ++b)
#pragma unroll
                for (int m = 0; m < 4; ++m)
#pragma unroll
                    for (int n = 0; n < 2; ++n) acc[a][b][m][n] = (f32x4){0.f, 0.f, 0.f, 0.f};
        cur = nxt; cA = nA; cB = nB; ++ui;
#pragma unroll
        for (int i = 0; i < 2; ++i) { vA0c[i] = vA0n[i]; vA1c[i] = vA1n[i]; }
        if (wr == 1) PG8_BAR;
    }
    PG8_WAIT_V(0);
    PG8_BAR;
#undef PG8_ROWS
#undef PG8_SEL
#undef PG8_SA
#undef PG8_SB
#undef PG8_STAGE
#undef PG8_LDA
#undef PG8_LDB
#undef PG8_MMA
#undef PG8_WAIT_V
#undef PG8_WAIT_L
#undef PG8_BAR
#undef PG8_SCHED
}

typedef f32x4 AccT[2][2][4][2];
__device__ __forceinline__ u32x4 pack8(const f32x4& v0, const f32x4& v1) { u32x4 w; w.x = cvt_pk_bf16(v0[0], v0[1]); w.y = cvt_pk_bf16(v0[2], v0[3]); w.z = cvt_pk_bf16(v1[0], v1[1]); w.w = cvt_pk_bf16(v1[2], v1[3]); return w; }
__device__ __forceinline__ void unpack8(const u32x4& w, f32x4& v0, f32x4& v1) { v0 = (f32x4){bf_lo(w.x), bf_hi(w.x), bf_lo(w.y), bf_hi(w.y)}; v1 = (f32x4){bf_lo(w.z), bf_hi(w.z), bf_lo(w.w), bf_hi(w.w)}; }
__device__ __forceinline__ float sigmoidf_(float v) { return frcp(1.f + fexp2(-v * LOG2E)); }
__device__ __forceinline__ unsigned pack4_u8(const f32x4& v) { unsigned w = 0u; w = __builtin_amdgcn_cvt_pk_u8_f32(v[0], 0u, w); w = __builtin_amdgcn_cvt_pk_u8_f32(v[1], 1u, w); w = __builtin_amdgcn_cvt_pk_u8_f32(v[2], 2u, w); w = __builtin_amdgcn_cvt_pk_u8_f32(v[3], 3u, w); return w; }
__device__ __forceinline__ f32x4 unpack4_u8(unsigned w) { return (f32x4){(float)(w & 0xffu), (float)((w >> 8) & 0xffu), (float)((w >> 16) & 0xffu), (float)(w >> 24)}; }

struct EpiProj {
    bf16_t* proj; unsigned char* gates; const LAS float* bgate; int mode; unsigned* kmsq;
    __device__ __forceinline__ void operator()(const AccT& acc, const Unit& u, int wr, int wc, int fr, int fq) const {
        const int row0 = u.pm * BM + wr * 64 + fr;
        if (mode == 1 || u.pn < 9) {
            const int col0 = (mode == 1 ? C_QI : 0) + u.pn * BM + wc * 32 + 8 * fq; const float sc = (mode == 1) ? 1.f : (1.f / 32.f);
            const int nbj = ((mode == 1 && u.pn == 1) || (mode == 0 && u.pn == 8)) ? 1 : 2;
#pragma unroll
            for (int ai = 0; ai < 2; ++ai)
#pragma unroll
                for (int m = 0; m < 4; ++m) { bf16_t* rowp = proj + (size_t)(row0 + ai * HALF + m * 16) * PW + col0;
#pragma unroll
                    for (int bj = 0; bj < 2; ++bj) if (bj < nbj) *(u32x4*)(rowp + bj * HALF) = pack8(acc[ai][bj][m][0] * sc, acc[ai][bj][m][1] * sc); }
            if (mode == 0 && (u.pn == 2 || u.pn == 3 || (u.pn == 8 && wc < 2))) {
#pragma unroll
                for (int bj = 0; bj < 2; ++bj) if (bj < nbj) { float mxs = 0.f;
#pragma unroll
                    for (int ai = 0; ai < 2; ++ai)
#pragma unroll
                        for (int m = 0; m < 4; ++m) { const f32x4 a = acc[ai][bj][m][0] * sc, b = acc[ai][bj][m][1] * sc;
                            float ss = (a[0] * a[0] + a[1] * a[1]) + (a[2] * a[2] + a[3] * a[3]) + (b[0] * b[0] + b[1] * b[1]) + (b[2] * b[2] + b[3] * b[3]);
                            ss += __shfl_xor(ss, 16); ss += __shfl_xor(ss, 32); mxs = fmaxf(mxs, ss); }
                    mxs = fmaxf(mxs, __shfl_xor(mxs, 8)); mxs = fmaxf(mxs, __shfl_xor(mxs, 4)); mxs = fmaxf(mxs, __shfl_xor(mxs, 2)); mxs = fmaxf(mxs, __shfl_xor(mxs, 1));
                    const int g = (u.pn == 8) ? 16 + wc : (2 * (u.pn - 2) + bj) * 4 + wc;
                    if (fr == 0 && fq == 0) atomicMax(kmsq + (u.pm >> 3) * 20 + g, __float_as_uint(mxs)); }
            }
        } else {
            const int col0 = (u.pn - 9) * BM + wc * 64 + 16 * fq;
            f32x4 bv[2][2];
#pragma unroll
            for (int bj = 0; bj < 2; ++bj)
#pragma unroll
                for (int n = 0; n < 2; ++n) bv[bj][n] = *(const LAS f32x4*)(bgate + col0 + bj * 8 + 4 * n);
#pragma unroll
            for (int ai = 0; ai < 2; ++ai)
#pragma unroll
                for (int m = 0; m < 4; ++m) { u32x4 w;
#pragma unroll
                    for (int bj = 0; bj < 2; ++bj) { f32x4 v0 = acc[ai][bj][m][0] * (1.f / 32.f) + bv[bj][0], v1 = acc[ai][bj][m][1] * (1.f / 32.f) + bv[bj][1];
#pragma unroll
                        for (int j = 0; j < 4; ++j) { v0[j] = sigmoidf_(v0[j]) * 255.f; v1[j] = sigmoidf_(v1[j]) * 255.f; }
                        w[2 * bj] = pack4_u8(v0); w[2 * bj + 1] = pack4_u8(v1); }
                    *(u32x4*)(gates + (size_t)(row0 + ai * HALF + m * 16) * 2048 + col0) = w; }
        }
    }
};
template <bool SECOND> struct EpiBranch {
    const unsigned char* gates; bf16_t* merged; unsigned char* merged8; float sc;
    __device__ __forceinline__ void operator()(const AccT& acc, const Unit& u, int wr, int wc, int fr, int fq) const {
        const int row0 = u.pm * BM + wr * 64 + fr, col0 = u.pn * BM + wc * 32 + 8 * fq;
#pragma unroll
        for (int ai = 0; ai < 2; ++ai)
#pragma unroll
            for (int m = 0; m < 4; ++m) { const size_t row = (size_t)(row0 + ai * HALF + m * 16);
#pragma unroll
                for (int bj = 0; bj < 2; ++bj) { const int col = col0 + bj * HALF;
                    const u32x2 gw = *(const u32x2*)(gates + row * 2048 + (SECOND ? 1024 : 0) + col);
                    const f32x4 g0 = unpack4_u8(gw.x), g1 = unpack4_u8(gw.y);
                    f32x4 v0 = g0 * acc[ai][bj][m][0] * sc, v1 = g1 * acc[ai][bj][m][1] * sc;
                    if (SECOND) { const u32x4 pw = *(const u32x4*)(merged + row * 1024 + col); f32x4 p0, p1; unpack8(pw, p0, p1); v0 = (v0 + p0) * 8.f; v1 = (v1 + p1) * 8.f;
                        u32x2 w; w.x = pack4_fp8(v0[0], v0[1], v0[2], v0[3]); w.y = pack4_fp8(v1[0], v1[1], v1[2], v1[3]); *(u32x2*)(merged8 + row * 1024 + col) = w; }
                    else *(u32x4*)(merged + row * 1024 + col) = pack8(v0, v1); } }
    }
};
struct EpiBranchF {
    const unsigned char* gates; unsigned char* merged8;
    __device__ __forceinline__ void mid(AccT& acc, const Unit& u, int wr, int wc, int fr, int fq) const {
        unsigned gbase = (unsigned)(u.pm * BM + wr * 64 + fr) * 2048u + (unsigned)(u.pn * BM + wc * 64 + 16 * fq); asm volatile("" : "+v"(gbase));
#pragma unroll
        for (int ai = 0; ai < 2; ++ai) { asm volatile("" ::: "memory");
#pragma unroll
            for (int m = 0; m < 4; ++m) { const unsigned go = gbase + (unsigned)(ai * HALF + m * 16) * 2048u;
                const u32x4 ga = *(const u32x4*)(gates + go), gb = *(const u32x4*)(gates + (go + 1024));
#pragma unroll
                for (int bj = 0; bj < 2; ++bj) {
                    const f32x4 a0 = unpack4_u8(ga[2 * bj]), a1 = unpack4_u8(ga[2 * bj + 1]), b0 = unpack4_u8(gb[2 * bj]), b1 = unpack4_u8(gb[2 * bj + 1]);
#pragma unroll
                    for (int j = 0; j < 4; ++j) { acc[ai][bj][m][0][j] *= 2.f * a0[j] * frcp(fmaxf(b0[j], 1.f)); acc[ai][bj][m][1][j] *= 2.f * a1[j] * frcp(fmaxf(b1[j], 1.f)); } } } }
    }
    __device__ __forceinline__ void operator()(const AccT& acc, const Unit& u, int wr, int wc, int fr, int fq) const {
        unsigned rbase = (unsigned)(u.pm * BM + wr * 64 + fr) * 1024u + (unsigned)(u.pn * BM + wc * 64 + 16 * fq); asm volatile("" : "+v"(rbase));
        const unsigned cpart = rbase & 1023u, gbase = 2u * (rbase - cpart) + cpart;
#pragma unroll
        for (int ai = 0; ai < 2; ++ai)
#pragma unroll
            for (int m = 0; m < 4; ++m) { const unsigned go = gbase + (unsigned)(ai * HALF + m * 16) * 2048u, ro = rbase + (unsigned)(ai * HALF + m * 16) * 1024u;
                const u32x4 gb = *(const u32x4*)(gates + (go + 1024)); u32x4 w;
#pragma unroll
                for (int bj = 0; bj < 2; ++bj) {
                    const f32x4 b0 = unpack4_u8(gb[2 * bj]), b1 = unpack4_u8(gb[2 * bj + 1]);
                    f32x4 v0, v1;
#pragma unroll
                    for (int j = 0; j < 4; ++j) { v0[j] = acc[ai][bj][m][0][j] * fmaxf(b0[j], 1.f) * (1.f / (16.f * 255.f)); v1[j] = acc[ai][bj][m][1][j] * fmaxf(b1[j], 1.f) * (1.f / (16.f * 255.f)); }
                    w[2 * bj] = pack4_fp8(v0[0], v0[1], v0[2], v0[3]); w[2 * bj + 1] = pack4_fp8(v1[0], v1[1], v1[2], v1[3]); }
                *(u32x4*)(merged8 + ro) = w; }
    }
};
template <> struct EpiBadj<EpiBranchF> { static constexpr bool v = true; };
template <> struct EpiMid<EpiBranchF> { static constexpr bool v = true; };
struct EpiResid {
    const float* base; float* out; float sc;
    __device__ __forceinline__ void operator()(const AccT& acc, const Unit& u, int wr, int wc, int fr, int fq) const {
        const int row0 = u.pm * BM + wr * 64 + fr, col0 = u.pn * BM + wc * 32 + 8 * fq;
#pragma unroll
        for (int ai = 0; ai < 2; ++ai)
#pragma unroll
            for (int m = 0; m < 4; ++m) { const size_t off = (size_t)(row0 + ai * HALF + m * 16) * 1024 + col0;
#pragma unroll
                for (int bj = 0; bj < 2; ++bj) {
                    const f32x4 b0 = *(const f32x4*)(base + off + bj * HALF), b1 = *(const f32x4*)(base + off + bj * HALF + 4);
                    *(f32x4*)(out + off + bj * HALF) = b0 + acc[ai][bj][m][0] * sc; *(f32x4*)(out + off + bj * HALF + 4) = b1 + acc[ai][bj][m][1] * sc; } }
    }
};
struct EpiResidHb {
    const bf16_t* base; bf16_t* out; unsigned char* hb; const float* g; float sc;
    __device__ __forceinline__ void operator()(const AccT& acc, const Unit& u, int wr, int wc, int fr, int fq) const {
        int row0 = u.pm * BM + wr * 64 + fr; asm volatile("" : "+v"(row0));
        const int col0 = u.pn * BM + wc * 32 + 8 * fq;
        f32x4 gv[2][2];
#pragma unroll
        for (int bj = 0; bj < 2; ++bj)
#pragma unroll
            for (int n = 0; n < 2; ++n) gv[bj][n] = *(const f32x4*)(g + col0 + bj * HALF + 4 * n);
#pragma unroll
        for (int ai = 0; ai < 2; ++ai)
#pragma unroll
            for (int m = 0; m < 4; ++m) { const size_t off = (size_t)(row0 + ai * HALF + m * 16) * 1024 + col0;
#pragma unroll
                for (int bj = 0; bj < 2; ++bj) {
                    f32x4 b0, b1; unpack8(*(const u32x4*)(base + off + bj * HALF), b0, b1);
                    const f32x4 v0 = b0 + acc[ai][bj][m][0] * sc, v1 = b1 + acc[ai][bj][m][1] * sc;
                    *(u32x4*)(out + off + bj * HALF) = pack8(v0, v1);
                    const f32x4 s0 = v0 * gv[bj][0], s1 = v1 * gv[bj][1];
                    u32x2 w; w.x = pack4_fp8(s0[0], s0[1], s0[2], s0[3]); w.y = pack4_fp8(s1[0], s1[1], s1[2], s1[3]);
                    *(u32x2*)(hb + off + bj * HALF) = w; } }
    }
};
struct EpiResidSq {
    const float* base; bf16_t* out; unsigned char* hb; const float* g; float* rowss; float sc;
    __device__ __forceinline__ void operator()(const AccT& acc, const Unit& u, int wr, int wc, int fr, int fq) const {
        int row0 = u.pm * BM + wr * 64 + fr; asm volatile("" : "+v"(row0));
        const int col0 = u.pn * BM + wc * 32 + 8 * fq;
        f32x4 gv[2][2];
#pragma unroll
        for (int bj = 0; bj < 2; ++bj)
#pragma unroll
            for (int n = 0; n < 2; ++n) gv[bj][n] = *(const f32x4*)(g + col0 + bj * HALF + 4 * n);
#pragma unroll
        for (int ai = 0; ai < 2; ++ai)
#pragma unroll
            for (int m = 0; m < 4; ++m) { const int row = row0 + ai * HALF + m * 16; const size_t off = (size_t)row * 1024 + col0; float ss = 0.f;
#pragma unroll
                for (int bj = 0; bj < 2; ++bj) {
                    const f32x4 v0 = *(const f32x4*)(base + off + bj * HALF) + acc[ai][bj][m][0] * sc, v1 = *(const f32x4*)(base + off + bj * HALF + 4) + acc[ai][bj][m][1] * sc;
                    *(u32x4*)(out + off + bj * HALF) = pack8(v0, v1);
                    ss += (v0[0] * v0[0] + v0[1] * v0[1]) + (v0[2] * v0[2] + v0[3] * v0[3]) + (v1[0] * v1[0] + v1[1] * v1[1]) + (v1[2] * v1[2] + v1[3] * v1[3]);
                    const f32x4 s0 = v0 * gv[bj][0], s1 = v1 * gv[bj][1];
                    u32x2 w; w.x = pack4_fp8(s0[0], s0[1], s0[2], s0[3]); w.y = pack4_fp8(s1[0], s1[1], s1[2], s1[3]);
                    *(u32x2*)(hb + off + bj * HALF) = w; }
                ss += __shfl_xor(ss, 16); ss += __shfl_xor(ss, 32);
                if (fq == 0) atomicAdd(rowss + row, ss); }
    }
};
struct EpiRowScale {
    bf16_t* O; int ldc; const float* rowss; float sc;
    __device__ __forceinline__ void operator()(const AccT& acc, const Unit& u, int wr, int wc, int fr, int fq) const {
        int row0 = u.pm * BM + wr * 64 + fr; asm volatile("" : "+v"(row0));
        const int col0 = u.pn * BM + wc * 32 + 8 * fq;
#pragma unroll
        for (int ai = 0; ai < 2; ++ai)
#pragma unroll
            for (int m = 0; m < 4; ++m) { const int row = row0 + ai * HALF + m * 16; const float rs = rsqrtf(__hip_atomic_load(rowss + row, __ATOMIC_RELAXED, __HIP_MEMORY_SCOPE_AGENT) * (1.f / 1024.f) + EPS) * sc;
                bf16_t* rowp = O + (size_t)row * ldc + col0;
#pragma unroll
                for (int bj = 0; bj < 2; ++bj) *(u32x4*)(rowp + bj * HALF) = pack8(acc[ai][bj][m][0] * rs, acc[ai][bj][m][1] * rs); }
    }
};
struct EpiPlain {
    bf16_t* O; int ldc; float sc;
    __device__ __forceinline__ void operator()(const AccT& acc, const Unit& u, int wr, int wc, int fr, int fq) const {
        const int row0 = u.pm * BM + wr * 64 + fr, col0 = u.pn * BM + wc * 32 + 8 * fq;
#pragma unroll
        for (int ai = 0; ai < 2; ++ai)
#pragma unroll
            for (int m = 0; m < 4; ++m) { bf16_t* rowp = O + (size_t)(row0 + ai * HALF + m * 16) * ldc + col0;
#pragma unroll
                for (int bj = 0; bj < 2; ++bj) *(u32x4*)(rowp + bj * HALF) = pack8(acc[ai][bj][m][0] * sc, acc[ai][bj][m][1] * sc); }
    }
};
struct EpiSwiGLU {
    unsigned char* hmid; const float* sgate; const float* siv;
    __device__ __forceinline__ void operator()(const AccT& acc, const Unit& u, int wr, int wc, int fr, int fq) const {
        const int row0 = u.pm * BM + wr * 64 + fr, col0 = u.pn * HALF + wc * 32 + 8 * fq;
#pragma unroll
        for (int ai = 0; ai < 2; ++ai)
#pragma unroll
            for (int m = 0; m < 4; ++m) { const size_t row = (size_t)(row0 + ai * HALF + m * 16); const float gt = sgate[row] * 8.f, iv = siv[row];
                f32x4 v[2];
#pragma unroll
                for (int n = 0; n < 2; ++n)
#pragma unroll
                    for (int j = 0; j < 4; ++j) { const float a = acc[ai][0][m][n][j] * iv, b = acc[ai][1][m][n][j] * iv; v[n][j] = gt * a * sigmoidf_(a) * b; }
                u32x2 w; w.x = pack4_fp8(v[0][0], v[0][1], v[0][2], v[0][3]); w.y = pack4_fp8(v[1][0], v[1][1], v[1][2], v[1][3]);
                *(u32x2*)(hmid + row * DEXP + col0) = w; }
    }
};
struct EpiDown {
    unsigned char* y2; const int* sdest;
    __device__ __forceinline__ void operator()(const AccT& acc, const Unit& u, int wr, int wc, int fr, int fq) const {
        const int row0 = u.pm * BM + wr * 64 + fr, col0 = u.pn * BM + wc * 64 + 16 * fq;
#pragma unroll
        for (int ai = 0; ai < 2; ++ai)
#pragma unroll
            for (int m = 0; m < 4; ++m) { const int dest = sdest[row0 + ai * HALF + m * 16];
                if (dest >= 0) { u32x4 w;
#pragma unroll
                    for (int bj = 0; bj < 2; ++bj) { const f32x4 a = acc[ai][bj][m][0] * (1.f / 16.f), b = acc[ai][bj][m][1] * (1.f / 16.f);
                        w[2 * bj] = pack4_fp8(a[0], a[1], a[2], a[3]); w[2 * bj + 1] = pack4_fp8(b[0], b[1], b[2], b[3]); }
                    *(u32x4*)(y2 + (size_t)dest * 1024 + col0) = w; } }
    }
};
template <> struct EpiBadj<EpiDown> { static constexpr bool v = true; };
}

#define XB_TMO      128
#define XB_XCNT(j)  (256  + 64 * (j))
#define XB_XSUB(j)  (1280 + 64 * (j))
#define XB_XGEN(j)  (2304 + 64 * (j))
#define XB_TOP      3328
#define XB_TOPGEN   3392
#define XCD_BAR_WORDS 3456
#define XB_SPIN_CAP (1u << 18)
__device__ __forceinline__ unsigned xb_ld(unsigned* p)              { return __hip_atomic_load(p, __ATOMIC_RELAXED, __HIP_MEMORY_SCOPE_AGENT); }
__device__ __forceinline__ unsigned xb_add(unsigned* p, unsigned v) { return __hip_atomic_fetch_add(p, v, __ATOMIC_RELAXED, __HIP_MEMORY_SCOPE_AGENT); }
__device__ __forceinline__ unsigned xb_xcc_id() { return (unsigned)__builtin_amdgcn_s_getreg((3 << 11) | 20) & 0xFu; }
#define XB_SPIN(cond, bar) do { unsigned _sp = 0; while (cond) { __builtin_amdgcn_s_sleep(1); \
    if ((++_sp & 255u) == 0u) { if (xb_ld(&(bar)[XB_TMO])) break; if (_sp > XB_SPIN_CAP) { atomicAdd(&(bar)[XB_TMO], 1u); break; } } } } while (0)
struct XcdBarrier { unsigned* bar; unsigned x; volatile LAS unsigned* st; };
__device__ __forceinline__ XcdBarrier xcd_barrier_post(unsigned* bar, volatile LAS unsigned* st) {
    XcdBarrier b; b.bar = bar; b.x = xb_xcc_id(); b.st = st;
    if (threadIdx.x == 0) (void)xb_add(&bar[XB_XCNT(b.x)], 1u);
    return b;
}
__device__ __forceinline__ void xcd_barrier_complete(unsigned* bar, unsigned x, unsigned& nloc, unsigned& nx) {
    const unsigned G = gridDim.x * gridDim.y * gridDim.z;
    unsigned sum, cnt, mine, sp = 0u;
    for (;;) {
        sum = 0u; cnt = 0u; mine = 0u;
#pragma unroll
        for (unsigned j = 0; j < 16; ++j) { const unsigned c = xb_ld(&bar[XB_XCNT(j)]); sum += c; cnt += (c > 0u) ? 1u : 0u; mine = (j == x) ? c : mine; }
        if (sum == G) break;
        __builtin_amdgcn_s_sleep(1);
        if ((++sp & 255u) == 0u) { if (xb_ld(&bar[XB_TMO])) break; if (sp > XB_SPIN_CAP) { atomicAdd(&bar[XB_TMO], 1u); break; } }
    }
    nloc = mine > 0u ? mine : 1u; nx = cnt > 0u ? cnt : 1u;
}
__device__ __forceinline__ void xcd_barrier(const XcdBarrier& b) {
    asm volatile("s_waitcnt vmcnt(0)" ::: "memory");
    __syncthreads();
    if (threadIdx.x == 0) {
        unsigned* bar = b.bar;
        __builtin_amdgcn_s_waitcnt(0);
        unsigned nloc = b.st[0], nx = b.st[1];
        if (nloc == 0u) { xcd_barrier_complete(bar, b.x, nloc, nx); b.st[0] = nloc; b.st[1] = nx; }
        const unsigned old = xb_add(&bar[XB_XSUB(b.x)], 1u);
        const unsigned gen = old / nloc;
        if (old + 1u == (gen + 1u) * nloc) {
            __builtin_amdgcn_fence(__ATOMIC_RELEASE, "agent");
            asm volatile("s_waitcnt vmcnt(0)" ::: "memory");
            const unsigned og = xb_add(&bar[XB_TOP], 1u);
            const unsigned tg = og / nx;
            if (og + 1u == (tg + 1u) * nx) xb_add(&bar[XB_TOPGEN], 1u);
            else XB_SPIN(xb_ld(&bar[XB_TOPGEN]) == tg, bar);
            __builtin_amdgcn_fence(__ATOMIC_ACQUIRE, "agent");
            xb_add(&bar[XB_XGEN(b.x)], 1u);
            asm volatile("s_waitcnt vmcnt(0)" ::: "memory");
        } else {
            XB_SPIN(xb_ld(&bar[XB_XGEN(b.x)]) == gen, bar);
            __builtin_amdgcn_fence(__ATOMIC_ACQUIRE, "agent");
            asm volatile("s_waitcnt vmcnt(0)" ::: "memory");
        }
    }
    __syncthreads();
}

__device__ __forceinline__ void tr_item(const float* src, int src_ld, int nvalid, int n0, int k0, bf16_t* dst, int K, LAS float* scr, int lane) {
    const int nn = n0 + (lane & 31); const bool ok = nn < nvalid;
    float t[32];
#pragma unroll
    for (int i = 0; i < 32; ++i) t[i] = ok ? src[(size_t)(k0 + 2 * i + (lane >> 5)) * src_ld + nn] : 0.f;
#pragma unroll
    for (int i = 0; i < 32; ++i) scr[(2 * i + (lane >> 5)) * 33 + (lane & 31)] = t[i];
    LDS_WAIT(); asm volatile("" ::: "memory");
    const int c = lane & 7;
#pragma unroll
    for (int j = 0; j < 4; ++j) { const int n = (lane >> 3) + 8 * j; const LAS float* s = scr + (8 * c) * 33 + n;
        u32x4 o; o.x = cvt_pk_bf16(s[0 * 33], s[1 * 33]); o.y = cvt_pk_bf16(s[2 * 33], s[3 * 33]); o.z = cvt_pk_bf16(s[4 * 33], s[5 * 33]); o.w = cvt_pk_bf16(s[6 * 33], s[7 * 33]);
        *(u32x4*)(dst + (size_t)n * K + k0 + 8 * c) = o; }
    LDS_WAIT(); asm volatile("" ::: "memory");
}
template <bool GPERM = false>
__device__ __forceinline__ void tr_item8(const float* src, int src_ld, int nvalid, int n0, int k0, unsigned char* dst, int K, float scale, LAS float* scr, int lane) {
    const int nn = n0 + (lane & 31); const bool ok = nn < nvalid;
    float t[32];
#pragma unroll
    for (int i = 0; i < 32; ++i) t[i] = ok ? src[(size_t)(k0 + 2 * i + (lane >> 5)) * src_ld + nn] : 0.f;
#pragma unroll
    for (int i = 0; i < 32; ++i) scr[(2 * i + (lane >> 5)) * 33 + (lane & 31)] = t[i] * scale;
    LDS_WAIT(); asm volatile("" ::: "memory");
    const int c = lane & 7;
#pragma unroll
    for (int j = 0; j < 4; ++j) { const int n = (lane >> 3) + 8 * j; const LAS float* s = scr + (8 * c) * 33 + n;
        u32x2 o; o.x = pack4_fp8(s[0 * 33], s[1 * 33], s[2 * 33], s[3 * 33]); o.y = pack4_fp8(s[4 * 33], s[5 * 33], s[6 * 33], s[7 * 33]);
        const int drow = GPERM ? 256 * (n0 >> 8) + 128 * (j & 1) + 32 * ((n0 >> 6) & 3) + 8 * (((n0 >> 4) & 3) + (j >> 1)) + (lane >> 3) : n;
        *(u32x2*)(dst + (size_t)drow * K + k0 + 8 * c) = o; }
    LDS_WAIT(); asm volatile("" ::: "memory");
}
__device__ __forceinline__ void rms_row_bf16(const float* xrow, const float* g, bf16_t* orow, int lane) {
    const f32x4* xr = (const f32x4*)xrow + lane; const f32x4* gr = (const f32x4*)g + lane;
    f32x4 v[4]; float s = 0.f;
#pragma unroll
    for (int j = 0; j < 4; ++j) { v[j] = xr[64 * j]; s += (v[j].x * v[j].x + v[j].y * v[j].y) + (v[j].z * v[j].z + v[j].w * v[j].w); }
    const float r = rsqrtf(wave_sum(s) * (1.f / 1024.f) + EPS);
    u32x2* o8 = (u32x2*)orow + lane;
#pragma unroll
    for (int j = 0; j < 4; ++j) { const f32x4 gv = gr[64 * j]; u32x2 w; w.x = cvt_pk_bf16(v[j].x * r * gv.x, v[j].y * r * gv.y); w.y = cvt_pk_bf16(v[j].z * r * gv.z, v[j].w * r * gv.w); o8[64 * j] = w; }
}

template <bool ALSO_BF16>
__device__ __forceinline__ void rms_rows4_fp8(const float* x0, size_t rstride, const float* g, unsigned char* o80, bf16_t* o0, int lane) {
    f32x4 v[4][4];
#pragma unroll
    for (int q = 0; q < 4; ++q)
#pragma unroll
        for (int j = 0; j < 4; ++j) v[q][j] = ((const f32x4*)(x0 + q * rstride) + lane)[64 * j];
    const f32x4* gr = (const f32x4*)g + lane;
    f32x4 gv[4];
#pragma unroll
    for (int j = 0; j < 4; ++j) gv[j] = gr[64 * j];
#pragma unroll
    for (int q = 0; q < 4; ++q) { float s = 0.f;
#pragma unroll
        for (int j = 0; j < 4; ++j) s += (v[q][j].x * v[q][j].x + v[q][j].y * v[q][j].y) + (v[q][j].z * v[q][j].z + v[q][j].w * v[q][j].w);
        const float r = rsqrtf(wave_sum(s) * (1.f / 1024.f) + EPS);
        unsigned* o4 = (unsigned*)(o80 + q * rstride) + lane; u32x2* o8 = (u32x2*)(o0 + q * rstride) + lane;
#pragma unroll
        for (int j = 0; j < 4; ++j) { const float a = v[q][j].x * r * gv[j].x, b = v[q][j].y * r * gv[j].y, c = v[q][j].z * r * gv[j].z, d = v[q][j].w * r * gv[j].w;
            o4[64 * j] = pack4_fp8(a, b, c, d);
            if (ALSO_BF16) { u32x2 w; w.x = cvt_pk_bf16(a, b); w.y = cvt_pk_bf16(c, d); o8[64 * j] = w; } } }
}
template <bool ALSO_BF16>
__device__ __forceinline__ void rms_row_fp8(const float* xrow, const float* g, unsigned char* orow8, bf16_t* orow, int lane) {
    const f32x4* xr = (const f32x4*)xrow + lane; const f32x4* gr = (const f32x4*)g + lane;
    f32x4 v[4]; float s = 0.f;
#pragma unroll
    for (int j = 0; j < 4; ++j) { v[j] = xr[64 * j]; s += (v[j].x * v[j].x + v[j].y * v[j].y) + (v[j].z * v[j].z + v[j].w * v[j].w); }
    const float r = rsqrtf(wave_sum(s) * (1.f / 1024.f) + EPS);
    unsigned* o4 = (unsigned*)orow8 + lane; u32x2* o8 = (u32x2*)orow + lane;
#pragma unroll
    for (int j = 0; j < 4; ++j) { const f32x4 gv = gr[64 * j]; const float a = v[j].x * r * gv.x, b = v[j].y * r * gv.y, c = v[j].z * r * gv.z, d = v[j].w * r * gv.w;
        o4[64 * j] = pack4_fp8(a, b, c, d);
        if (ALSO_BF16) { u32x2 w; w.x = cvt_pk_bf16(a, b); w.y = cvt_pk_bf16(c, d); o8[64 * j] = w; } }
}
__device__ __forceinline__ s16x4 vtr(const LAS unsigned char* p) { return __builtin_bit_cast(s16x4, __builtin_amdgcn_ds_read_tr16_b64_v4i16((LAS s16x4*)p)); }

template <int N> struct QReg { const bf16x8 (&q)[N]; __device__ __forceinline__ bf16x8 get(int ks) const { return q[ks]; } };
struct QLds { const LAS unsigned char* p; __device__ __forceinline__ bf16x8 get(int ks) const { return *(const LAS bf16x8*)(p + ks * 32); } };
__device__ __forceinline__ float fmax3_(float a, float b, float c) { float r; asm("v_max3_f32 %0, %1, %2, %3" : "=v"(r) : "v"(a), "v"(b), "v"(c)); return r; }
__device__ __forceinline__ float fmax2_(float a, float b) { float r; asm("v_max_f32_e32 %0, %1, %2" : "=v"(r) : "v"(a), "v"(b)); return r; }
__device__ __forceinline__ float fadd_(float a, float b) { float r; asm("v_add_f32_e32 %0, %1, %2" : "=v"(r) : "v"(a), "v"(b)); return r; }
struct TileSc { float c1, c2, tt, fh; unsigned m0, m1; bool diag; };
template <int DQK, int DV, bool PVDB, bool BIAS, bool MASKED, class QS>
__device__ __forceinline__ void attn_tile(const LAS unsigned char* Kt, const int kpitch, const LAS unsigned char* Vt, const int vpitch,
                                          const QS& qf, f32x16 (&o)[DV / 32], float& m_run, float& l_run, const TileSc& sc, const f32x16& kb0, const f32x16& kb1, const int lane) {
    const int r32 = lane & 31, hi = lane >> 5;
    f32x16 p0, p1;
    const LAS unsigned char* kp = Kt + r32 * kpitch + hi * 16;
    {
        const bf16x8 k0 = *(const LAS bf16x8*)(kp), k1 = *(const LAS bf16x8*)(kp + 32 * kpitch); const bf16x8 qv = qf.get(0);
        if (BIAS && !sc.diag) { p0 = __builtin_amdgcn_mfma_f32_32x32x16_bf16(k0, qv, kb0, 0, 0, 0); p1 = __builtin_amdgcn_mfma_f32_32x32x16_bf16(k1, qv, kb1, 0, 0, 0); }
        else { f32x16 z;
#pragma unroll
            for (int r = 0; r < 16; ++r) z[r] = 0.f;
            p0 = __builtin_amdgcn_mfma_f32_32x32x16_bf16(k0, qv, z, 0, 0, 0); p1 = __builtin_amdgcn_mfma_f32_32x32x16_bf16(k1, qv, z, 0, 0, 0); }
    }
#pragma unroll
    for (int ks = 1; ks < DQK / 16; ++ks) {
        const bf16x8 k0 = *(const LAS bf16x8*)(kp + ks * 32);
        const bf16x8 k1 = *(const LAS bf16x8*)(kp + 32 * kpitch + ks * 32);
        const bf16x8 qv = qf.get(ks);
        p0 = __builtin_amdgcn_mfma_f32_32x32x16_bf16(k0, qv, p0, 0, 0, 0);
        p1 = __builtin_amdgcn_mfma_f32_32x32x16_bf16(k1, qv, p1, 0, 0, 0);
    }
    float cm = sc.c1;
    if (BIAS && sc.diag) {
#pragma unroll
        for (int r = 0; r < 16; ++r) { const float k0 = sc.c2 * ((float)((r & 3) + 8 * (r >> 2)) + sc.fh), k1 = k0 + 32.f * sc.c2;
            p0[r] = p0[r] * sc.c1 + fminf(k0, sc.tt - k0); p1[r] = p1[r] * sc.c1 + fminf(k1, sc.tt - k1); }
        cm = 1.f;
    }
    if (MASKED) {
#pragma unroll
        for (int r = 0; r < 16; ++r) { const int cp = (r & 3) + 8 * (r >> 2);
            const unsigned t0 = (unsigned)__builtin_amdgcn_sbfe((int)sc.m0, cp, 1), t1 = (unsigned)__builtin_amdgcn_sbfe((int)sc.m1, cp, 1);
            p0[r] = __uint_as_float((__float_as_uint(p0[r]) & t0) | (0xff800000u & ~t0)); p1[r] = __uint_as_float((__float_as_uint(p1[r]) & t1) | (0xff800000u & ~t1)); }
    }
    asm volatile("s_nop 15\n\ts_nop 7" : "+v"(p0), "+v"(p1));
    float mx;
    { float a = fmax3_(p0[0], p0[1], p1[0]), b = fmax3_(p0[2], p0[3], p1[1]); a = fmax3_(a, p1[2], p1[3]);
#pragma unroll
      for (int r = 4; r < 16; r += 4) { a = fmax3_(a, p0[r], p0[r + 1]); b = fmax3_(b, p0[r + 2], p0[r + 3]); a = fmax3_(a, p1[r], p1[r + 1]); b = fmax3_(b, p1[r + 2], p1[r + 3]); }
      mx = fmax2_(a, b);
      const auto rr = __builtin_amdgcn_permlane32_swap(__float_as_uint(mx), __float_as_uint(mx), false, false);
      mx = fmax2_(__uint_as_float(rr[0]), __uint_as_float(rr[1])) * cm; }
    if (__any(mx > m_run)) {
        const float mnew = fmaxf(m_run, mx);
        const float alpha = fexp2(m_run - mnew);
        m_run = mnew; l_run *= alpha;
#pragma unroll
        for (int e = 0; e < DV / 32; ++e)
#pragma unroll
            for (int r = 0; r < 16; ++r) o[e][r] *= alpha;
    }
    if (!__any(mx > m_run - 40.f)) return;
    const float nm = -m_run;
#pragma unroll
    for (int r = 0; r < 16; ++r) { p0[r] = fexp2(__builtin_fmaf(p0[r], cm, nm)); p1[r] = fexp2(__builtin_fmaf(p1[r], cm, nm)); }
    { float s0 = p0[0] + p1[0], s1 = p0[1] + p1[1], s2 = p0[2] + p1[2], s3 = p0[3] + p1[3];
#pragma unroll
      for (int r = 4; r < 16; r += 4) { s0 += p0[r] + p1[r]; s1 += p0[r + 1] + p1[r + 1]; s2 += p0[r + 2] + p1[r + 2]; s3 += p0[r + 3] + p1[r + 3]; }
      l_run += (s0 + s1) + (s2 + s3); }
    u32x4 pw[4];
#pragma unroll
    for (int i = 0; i < 4; ++i) { pw[0][i] = cvt_pk_bf16(p0[2 * i], p0[2 * i + 1]); pw[1][i] = cvt_pk_bf16(p0[8 + 2 * i], p0[8 + 2 * i + 1]);
                                  pw[2][i] = cvt_pk_bf16(p1[2 * i], p1[2 * i + 1]); pw[3][i] = cvt_pk_bf16(p1[8 + 2 * i], p1[8 + 2 * i + 1]); }
    const int g = lane >> 4, i16 = lane & 15;
    const LAS unsigned char* vp = Vt + (4 * hi + (i16 >> 2)) * vpitch + ((g & 1) * 16 + 4 * (i16 & 3)) * 2;
    constexpr int NE = DV / 32;
    if constexpr (!PVDB) {
#pragma unroll
        for (int s = 0; s < 4; ++s) {
            const bf16x8 pa = __builtin_bit_cast(bf16x8, pw[s]);
#pragma unroll
            for (int e = 0; e < NE; ++e) {
                const s16x4 lo = vtr(vp + (16 * s) * vpitch + e * 64), hh = vtr(vp + (16 * s + 8) * vpitch + e * 64);
                const bf16x8 vf = (bf16x8){lo[0], lo[1], lo[2], lo[3], hh[0], hh[1], hh[2], hh[3]};
                o[e] = __builtin_amdgcn_mfma_f32_32x32x16_bf16(vf, pa, o[e], 0, 0, 0);
            }
        }
        return;
    }
    s16x4 vlo[2][NE], vhi[2][NE];
#pragma unroll
    for (int e = 0; e < NE; ++e) { vlo[0][e] = vtr(vp + e * 64); vhi[0][e] = vtr(vp + 8 * vpitch + e * 64); }
#pragma unroll
    for (int s = 0; s < 4; ++s) {
        if (s + 1 < 4) {
#pragma unroll
            for (int e = 0; e < NE; ++e) { vlo[(s + 1) & 1][e] = vtr(vp + (16 * (s + 1)) * vpitch + e * 64); vhi[(s + 1) & 1][e] = vtr(vp + (16 * (s + 1) + 8) * vpitch + e * 64); }
        }
        const bf16x8 pa = __builtin_bit_cast(bf16x8, pw[s]);
#pragma unroll
        for (int e = 0; e < NE; ++e) {
            const s16x4 lo = vlo[s & 1][e], hh = vhi[s & 1][e];
            const bf16x8 vf = (bf16x8){lo[0], lo[1], lo[2], lo[3], hh[0], hh[1], hh[2], hh[3]};
            o[e] = __builtin_amdgcn_mfma_f32_32x32x16_bf16(vf, pa, o[e], 0, 0, 0);
        }
    }
}
template <int ROWB> struct TileRegs { u32x4 v[(64 * ROWB / 16) / 512]; };
template <int ROWB>
__device__ __forceinline__ void tile_load(TileRegs<ROWB>& t, const bf16_t* gsrc, size_t gpitch_el, int tid) {
    constexpr int CPR = ROWB / 16, TOTAL = 64 * CPR;
#pragma unroll
    for (int c = 0; c < TOTAL / 512; ++c) { const int idx = tid + c * 512, row = idx / CPR, ch = idx % CPR;
        t.v[c] = *(const u32x4*)(gsrc + (size_t)row * gpitch_el + ch * 8); }
}
template <int ROWB>
__device__ __forceinline__ void tile_store(const TileRegs<ROWB>& t, LAS unsigned char* dst, int lpitch, int tid) {
    constexpr int CPR = ROWB / 16, TOTAL = 64 * CPR;
#pragma unroll
    for (int c = 0; c < TOTAL / 512; ++c) { const int idx = tid + c * 512, row = idx / CPR, ch = idx % CPR;
        *(LAS u32x4*)(dst + row * lpitch + ch * 16) = t.v[c]; }
}
template <int ROWB>
__device__ __forceinline__ void stage_tile(const bf16_t* gsrc, size_t gpitch_el, LAS unsigned char* dst, int lpitch, int tid) {
    constexpr int CPR = ROWB / 16, TOTAL = 64 * CPR;
#pragma unroll
    for (int c = 0; c < TOTAL / 512; ++c) { const int idx = tid + c * 512, row = idx / CPR, ch = idx % CPR;
        const u32x4 v = *(const u32x4*)(gsrc + (size_t)row * gpitch_el + ch * 8);
        *(LAS u32x4*)(dst + row * lpitch + ch * 16) = v; }
}
template <int NE>
__device__ __forceinline__ void store_ot(const f32x16 (&o)[NE], float scale, bf16_t* rowp, int hi) {
#pragma unroll
    for (int e = 0; e < NE; ++e)
#pragma unroll
        for (int g4 = 0; g4 < 4; ++g4) { u32x2 w; w.x = cvt_pk_bf16(o[e][4 * g4] * scale, o[e][4 * g4 + 1] * scale); w.y = cvt_pk_bf16(o[e][4 * g4 + 2] * scale, o[e][4 * g4 + 3] * scale);
            *(u32x2*)(rowp + 32 * e + 8 * g4 + 4 * hi) = w; }
}

template <int NE>
__device__ __forceinline__ void store_ot8(const f32x16 (&o)[NE], float scale, unsigned char* rowp, int hi) {
#pragma unroll
    for (int e = 0; e < NE; ++e)
#pragma unroll
        for (int g4 = 0; g4 < 4; ++g4) *(unsigned*)(rowp + 32 * e + 8 * g4 + 4 * hi) = pack4_fp8(o[e][4 * g4] * scale, o[e][4 * g4 + 1] * scale, o[e][4 * g4 + 2] * scale, o[e][4 * g4 + 3] * scale);
}
template <int NE>
__device__ __forceinline__ void rows_out8(const LAS unsigned char* scr, unsigned char* grow0, const size_t gpitch, const int lane) {
    constexpr int PITCH = 32 * NE + 16, CH = 2 * NE, RPI = 64 / CH;
    const int rr = lane / CH, ch = lane % CH;
#pragma unroll
    for (int it = 0; it < 32 / RPI; ++it) { const int row = it * RPI + rr;
        const u32x4 v = *(const LAS u32x4*)(scr + row * PITCH + ch * 16); *(u32x4*)(grow0 + (size_t)row * gpitch + ch * 16) = v; }
}
template <int NE>
__device__ __forceinline__ void store_ot8_rows(const f32x16 (&o)[NE], float scale, LAS unsigned char* scr, unsigned char* grow0, const size_t gpitch, const int lane) {
    constexpr int PITCH = 32 * NE + 16; const int r32 = lane & 31, hi = lane >> 5;
#pragma unroll
    for (int e = 0; e < NE; ++e)
#pragma unroll
        for (int g4 = 0; g4 < 4; ++g4) *(LAS unsigned*)(scr + r32 * PITCH + 32 * e + 8 * g4 + 4 * hi) = pack4_fp8(o[e][4 * g4] * scale, o[e][4 * g4 + 1] * scale, o[e][4 * g4 + 2] * scale, o[e][4 * g4 + 3] * scale);
    rows_out8<NE>(scr, grow0, gpitch, lane);
}
__device__ __forceinline__ void make_kb(f32x16& kb0, f32x16& kb1, float c1, float c2, int hi) {
#pragma unroll
    for (int r = 0; r < 16; ++r) { kb0[r] = c2 * (float)((r & 3) + 8 * (r >> 2) + 4 * hi) / c1; kb1[r] = kb0[r] + 32.f * c2 / c1; }
}

__device__ __forceinline__ float score_bound(const bf16x8 (&qf)[4], const unsigned* km, const float c1, const float c2) {
    const float kmax2 = __uint_as_float(__hip_atomic_load(km, __ATOMIC_RELAXED, __HIP_MEMORY_SCOPE_AGENT)) + __uint_as_float(__hip_atomic_load(km + 1, __ATOMIC_RELAXED, __HIP_MEMORY_SCOPE_AGENT));
    float qs = 0.f;
#pragma unroll
    for (int ks = 0; ks < 4; ++ks) { const u32x4 w = __builtin_bit_cast(u32x4, qf[ks]);
#pragma unroll
        for (int i = 0; i < 4; ++i) { const float a = bf_lo(w[i]), b = bf_hi(w[i]); qs += a * a + b * b; } }
    qs = xor32_sum(qs);
    return 1.02f * c1 * sqrtf(qs * kmax2) + 63.f * c2 + 40.01f;
}

__device__ __forceinline__ void diffattn_unit(const bf16_t* proj, unsigned char* ya, const float* subln, const float lam, const unsigned* kmsq, const int b, const int h, const int qb,
                                              LAS unsigned char* lds, const int tid_in) {
    int tid = tid_in; asm volatile("" : "+v"(tid));
    const int wave = __builtin_amdgcn_readfirstlane(tid >> 6), lane = tid & 63, r32 = lane & 31, hi = lane >> 5;
    const int sb = wave & 3, mm = wave >> 2;
    const LAS float* subl = (const LAS float*)(lds + 131072); (void)subln;
    const int t0 = qb * 128 + sb * 32;
    const size_t rowbase = (size_t)b * SEQ;
    bf16x8 qf[4];
    { const bf16_t* qp = proj + (rowbase + t0 + r32) * PW + C_QA + h * 128 + mm * 64 + hi * 8;
#pragma unroll
      for (int ks = 0; ks < 4; ++ks) qf[ks] = *(const bf16x8*)(qp + ks * 16); }
    f32x16 o[4];
#pragma unroll
    for (int e = 0; e < 4; ++e)
#pragma unroll
        for (int r = 0; r < 16; ++r) o[e][r] = 0.f;
    float m_run = -1e30f, l_run = 0.f;
    const int nt = 2 * qb + 2, ntw = (t0 >> 6) + 1;
    constexpr int KP = 272, VP = 320, KB = 64 * KP, BUFB = 64 * KP + 64 * VP;
    const float c2 = exp2f(-2.f * (float)(h + 1)) * LOG2E;
    TileSc sf; sf.c1 = 0.125f * LOG2E; sf.c2 = c2; sf.fh = (float)(4 * hi); sf.tt = 2.f * c2 * (float)((t0 & 63) + r32); sf.m0 = 0u; sf.m1 = 0u; sf.diag = false;
    const bf16_t* src = proj + rowbase * PW + h * 128;
    TileRegs<256> kr, vr;
    { const bf16_t* s0 = src + (size_t)(64 * (nt - 1)) * PW; tile_load<256>(kr, s0 + C_KA, PW, tid); tile_load<256>(vr, s0 + C_VA, PW, tid); }
    tile_store<256>(kr, lds, KP, tid); tile_store<256>(vr, lds + KB, VP, tid);
#pragma unroll
    for (int ks = 0; ks < 4; ++ks) asm volatile("" : "+v"(qf[ks]));
    const float qbnd = score_bound(qf, kmsq + b * 20 + h * 4 + mm * 2, sf.c1, c2);
    LAS unsigned* dead = (LAS unsigned*)(lds + MISC_OFF + 160);
    if (tid == 0) { dead[0] = 0u; dead[1] = 0u; }
    LAS float* biasT = (LAS float*)(lds + 131072 + 1024);
    if (tid < 64) { const int e = tid & 31, r = e & 15; biasT[tid] = (c2 / sf.c1) * (float)((r & 3) + 8 * (r >> 2) + 4 * (tid >> 5) + 32 * (e >> 4)); }
    bool live = true;
    __syncthreads();
    for (int it = 0; it < nt; ++it) {
        const int j = nt - 1 - it;
        LAS unsigned char* kb = lds + (it & 1) * BUFB; LAS unsigned char* nb = lds + ((it + 1) & 1) * BUFB;
        if (j > 0) { const bf16_t* sn = src + (size_t)(64 * (j - 1)) * PW; tile_load<256>(kr, sn + C_KA, PW, tid); tile_load<256>(vr, sn + C_VA, PW, tid); }
        if (live && j < ntw - 1 && !__any(qbnd > m_run)) { live = false; if (lane == 0) { atomicMax((unsigned*)(dead + 1), (unsigned)it); atomicAdd((unsigned*)dead, 1u); } }
        if (live && j < ntw) { sf.diag = (j == ntw - 1);
            int boff = hi * 128; asm volatile("" : "+v"(boff));
            f32x16 kb0, kb1;
            { const LAS f32x4* bt = (const LAS f32x4*)((const LAS unsigned char*)biasT + boff);
#pragma unroll
              for (int g4 = 0; g4 < 4; ++g4) { const f32x4 a = bt[g4], b = bt[4 + g4];
#pragma unroll
                  for (int i = 0; i < 4; ++i) { kb0[4 * g4 + i] = a[i]; kb1[4 * g4 + i] = b[i]; } } }
            attn_tile<64, 128, true, true, false>(kb + mm * 128, KP, kb + KB, VP, QReg<4>{qf}, o, m_run, l_run, sf, kb0, kb1, lane); m_run += 64.f * c2; }
        if (j > 0) { tile_store<256>(kr, nb, KP, tid); tile_store<256>(vr, nb + KB, VP, tid); }
        __syncthreads();
        { const u32x2 dd = *(const volatile LAS u32x2*)dead; if (dd.x == 8u && dd.y <= (unsigned)it) break; }
    }
    const float ltot = xor32_sum(l_run);
    const float inv = 1.f / ltot;
    LAS float* X = (LAS float*)lds + sb * 4096;
    if (mm == 1) {
#pragma unroll
        for (int e = 0; e < 4; ++e)
#pragma unroll
            for (int r = 0; r < 16; ++r) X[(32 * e + crow(r, hi)) * 32 + r32] = o[e][r] * inv;
    }
    __syncthreads();
    if (mm == 0) {
        float ss = 0.f;
#pragma unroll
        for (int e = 0; e < 4; ++e) {
#pragma unroll
            for (int r = 0; r < 16; ++r) { const float d = o[e][r] * inv - lam * X[(32 * e + crow(r, hi)) * 32 + r32]; o[e][r] = d; ss += d * d; }
            __builtin_amdgcn_sched_barrier(0);
        }
        ss = xor32_sum(ss);
        const float rn = rsqrtf(ss * (1.f / 128.f) + EPS) * 0.8f * 4.f;
        LAS unsigned char* scr = (LAS unsigned char*)X;
#pragma unroll
        for (int e = 0; e < 4; ++e) {
#pragma unroll
            for (int g4 = 0; g4 < 4; ++g4) { const f32x4 sv = *(const LAS f32x4*)(subl + 32 * e + 8 * g4 + 4 * hi);
                *(LAS unsigned*)(scr + r32 * 144 + 32 * e + 8 * g4 + 4 * hi) = pack4_fp8(o[e][4 * g4] * rn * sv[0], o[e][4 * g4 + 1] * rn * sv[1], o[e][4 * g4 + 2] * rn * sv[2], o[e][4 * g4 + 3] * rn * sv[3]); }
            __builtin_amdgcn_sched_barrier(0);
        }
        rows_out8<4>(scr, ya + (rowbase + t0) * 1024 + h * 128, 1024, lane);
    }
    __syncthreads();
}

__device__ __forceinline__ unsigned f32_to_sortable16(float x) {
    const _Float16 hx = (_Float16)x; const unsigned b = (unsigned)__builtin_bit_cast(unsigned short, hx);
    return (b & 0x8000u) ? (~b & 0xffffu) : (b | 0x8000u);
}
__device__ __forceinline__ unsigned pk_count_gt(unsigned cnt, unsigned x, unsigned c) {
    unsigned d;
    asm("v_pk_sub_u16 %0, %1, %2 clamp" : "=v"(d) : "v"(x), "v"(c));
    asm("v_pk_min_u16 %0, %1, 1 op_sel_hi:[1,0]" : "=v"(d) : "v"(d));
    asm("v_pk_add_u16 %0, %1, %2" : "=v"(cnt) : "v"(cnt), "v"(d));
    return cnt;
}
__device__ __forceinline__ unsigned pk_wrapsum(unsigned acc, unsigned x, unsigned c2) {
    unsigned d;
    asm("v_pk_sub_u16 %0, %1, %2" : "=v"(d) : "v"(c2), "v"(x));
    asm("v_sad_u16 %0, %1, 0, %2" : "=v"(acc) : "v"(d), "v"(acc));
    return acc;
}
__device__ __forceinline__ unsigned nib_gt(unsigned x, unsigned y, unsigned c2) {
    unsigned gx, gy;
    asm("v_pk_sub_u16 %0, %1, %2 clamp" : "=v"(gx) : "v"(x), "v"(c2)); asm("v_pk_min_u16 %0, %1, 1 op_sel_hi:[1,0]" : "=v"(gx) : "v"(gx));
    asm("v_pk_sub_u16 %0, %1, %2 clamp" : "=v"(gy) : "v"(y), "v"(c2)); asm("v_pk_min_u16 %0, %1, 1 op_sel_hi:[1,0]" : "=v"(gy) : "v"(gy));
    return __builtin_amdgcn_udot4(__builtin_amdgcn_perm(gy, gx, 0x06040200u), 0x08040201u, 0u, false);
}
__device__ __forceinline__ int grp16_sum(int v) {
    v += __builtin_amdgcn_update_dpp(0, v, 0x128, 0xf, 0xf, false);
    v += __builtin_amdgcn_update_dpp(0, v, 0x124, 0xf, 0xf, false);
    v += __builtin_amdgcn_update_dpp(0, v, 0x122, 0xf, 0xf, false);
    v += __builtin_amdgcn_update_dpp(0, v, 0x121, 0xf, 0xf, false);
    return v;
}
__device__ __forceinline__ int grp16_incl_scan(int v) {
    v += __builtin_amdgcn_update_dpp(0, v, 0x111, 0xf, 0xf, true);
    v += __builtin_amdgcn_update_dpp(0, v, 0x112, 0xf, 0xf, true);
    v += __builtin_amdgcn_update_dpp(0, v, 0x114, 0xf, 0xf, true);
    v += __builtin_amdgcn_update_dpp(0, v, 0x118, 0xf, 0xf, true);
    return v;
}

__device__ __forceinline__ void dsa_unit(const bf16_t* proj, unsigned char* yb, const unsigned* kmsq, const int b, const int qblk, LAS unsigned char* lds, const int tid_in) {
    int tid = tid_in; asm volatile("" : "+v"(tid));
    const int wave = __builtin_amdgcn_readfirstlane(tid >> 6), lane = tid & 63, r32 = lane & 31, hi = lane >> 5;
    const int t0 = qblk * 32, nt = (t0 >> 6) + 1;
    const size_t rowbase = (size_t)b * SEQ;
    const bool need_sel = nt > 4;
    LAS unsigned* mask = (LAS unsigned*)(lds + MASK_OFF);
    bf16x8 qf[4]; TileRegs<128> kr, vr;
#define DSA_FIRST_LOADS() do { const bf16_t* qp_ = proj + (rowbase + t0 + r32) * PW + C_QB + wave * 64 + hi * 8; \
        _Pragma("unroll") for (int ks = 0; ks < 4; ++ks) qf[ks] = *(const bf16x8*)(qp_ + ks * 16); \
        const bf16_t* s0_ = proj + rowbase * PW + (size_t)(64 * (nt - 1)) * PW; tile_load<128>(kr, s0_ + C_KB, PW, tid); tile_load<128>(vr, s0_ + C_VB, PW, tid); } while (0)
    if (!need_sel) DSA_FIRST_LOADS();
    if (need_sel) for (int rep2_ = 0; rep2_ < REPS(102); ++rep2_) {
        for (int i = tid; i < 32 * MASK_PITCH_W; i += 512) mask[i] = 0u;
        const int rs8 = (nt | 1) * 8; const float inv_nt = 1.f / (float)nt;
        {
            bf16x8 qi[4][4]; float w[4];
            const bf16_t* qrow = proj + (rowbase + t0 + r32) * PW;
            LAS unsigned char* QI = lds + QIDX_OFF;
            { const bf16_t* qsrc = proj + (rowbase + t0) * PW + C_QI;
#pragma unroll
              for (int c = 0; c < 2; ++c) { const int idx = tid + c * 512, row = idx >> 5, ch = idx & 31;
                  const u32x4 v = *(const u32x4*)(qsrc + (size_t)row * PW + ch * 8); *(LAS u32x4*)(QI + row * 528 + ch * 16) = v; } }
#pragma unroll
            for (int hh = 0; hh < 4; ++hh) w[hh] = bf2f(qrow[C_WI + hh]) * 0.0625f;
            __syncthreads();
#pragma unroll
            for (int hh = 0; hh < 4; ++hh)
#pragma unroll
                for (int ks = 0; ks < 4; ++ks) qi[hh][ks] = *(const LAS bf16x8*)(QI + r32 * 528 + (hh * 64 + ks * 16 + hi * 8) * 2);
            const bf16_t* kbase = proj + (rowbase + r32) * PW + C_KI + hi * 8;
            bf16x8 kf[4], kn[4];
            if (wave < 2 * nt) {
#pragma unroll
                for (int ks = 0; ks < 4; ++ks) kf[ks] = *(const bf16x8*)(kbase + (size_t)(32 * wave) * PW + ks * 16); }
#pragma unroll 1
            for (int it = wave; it < 2 * nt; it += 8) {
                const int j = it >> 1, blk = it & 1; const int nx = (it + 8 < 2 * nt) ? it + 8 : it;
#pragma unroll
                for (int ks = 0; ks < 4; ++ks) kn[ks] = *(const bf16x8*)(kbase + (size_t)(32 * nx) * PW + ks * 16);
                f32x16 isc;
#pragma unroll
                for (int r = 0; r < 16; ++r) isc[r] = 0.f;
#pragma unroll
                for (int hh = 0; hh < 4; ++hh) { f32x16 a;
#pragma unroll
                    for (int r = 0; r < 16; ++r) a[r] = 0.f;
#pragma unroll
                    for (int ks = 0; ks < 4; ++ks) a = __builtin_amdgcn_mfma_f32_32x32x16_bf16(kf[ks], qi[hh][ks], a, 0, 0, 0);
#pragma unroll
                    for (int r = 0; r < 16; ++r) isc[r] += w[hh] * fmaxf(a[r], 0.f); }
#pragma unroll
                for (int g4 = 0; g4 < 4; ++g4) {
                    const unsigned u0 = f32_to_sortable16(isc[4 * g4]), u1 = f32_to_sortable16(isc[4 * g4 + 1]), u2 = f32_to_sortable16(isc[4 * g4 + 2]), u3 = f32_to_sortable16(isc[4 * g4 + 3]);
                    const int kq = 16 * j + 8 * blk + 2 * g4 + hi;
                    const int rg = (int)(((float)kq + 0.5f) * inv_nt);
                    u32x2 w2; w2.x = u0 | (u1 << 16); w2.y = u2 | (u3 << 16);
                    *(LAS u32x2*)(lds + r32 * ISC_PITCH + rg * rs8 + (kq - rg * nt) * 8) = w2;
                }
#pragma unroll
                for (int ks = 0; ks < 4; ++ks) kf[ks] = kn[ks];
            }
        }
        DSA_FIRST_LOADS();
        __syncthreads();
        {
            const int q = tid >> 4, sub = tid & 15;
            const LAS unsigned char* base = lds + q * ISC_PITCH + sub * rs8;
            u32x2 v[32];
#pragma unroll
            for (int g = 0; g < 4; ++g) {
                if (8 * g < nt) {
#pragma unroll
                    for (int i = 8 * g; i < 8 * g + 8; ++i) { const u32x2 x = *(const LAS u32x2*)(base + 8 * i); const bool ok = i < nt; v[i].x = ok ? x.x : 0u; v[i].y = ok ? x.y : 0u; }
                } else {
#pragma unroll
                    for (int i = 8 * g; i < 8 * g + 8; ++i) { v[i].x = 0u; v[i].y = 0u; } } }
            unsigned T = 0u;
            const int ngrp = (nt + 7) >> 3;
            int xtot, xthr;
            { unsigned xs = 0u;
#pragma unroll
              for (int g = 0; g < 4; ++g) if (g < ngrp) {
#pragma unroll
                for (int i = 8 * g; i < 8 * g + 8; ++i) { asm("v_sad_u16 %0, %1, 0, %2" : "=v"(xs) : "v"(v[i].x), "v"(xs)); asm("v_sad_u16 %0, %1, 0, %2" : "=v"(xs) : "v"(v[i].y), "v"(xs)); } }
              xthr = (int)xs; xtot = grp16_sum((int)xs); }
            const int ntot = 64 * nt;
            {
                unsigned tb[32];
#pragma unroll
                for (int i = 0; i < 32; ++i) tb[i] = (i < nt) ? __builtin_amdgcn_perm(v[i].y, v[i].x, 0x07050301u) : 0u;
                const int ntot_b = 512 * ngrp;
                unsigned Th = 0u;
                for (int bit = 7; bit >= 0; --bit) {
                    const unsigned ch = Th | (1u << bit); const unsigned c4 = ch * 0x01010101u, m4 = (ch - 1u) * 0x01010101u; unsigned a1 = 0u, a2 = 0u;
#pragma unroll
                    for (int g = 0; g < 4; ++g) if (g < ngrp) {
#pragma unroll
                        for (int i = 8 * g; i < 8 * g + 8; ++i) { asm("v_sad_u8 %0, %1, %2, %3" : "=v"(a1) : "v"(tb[i]), "v"(m4), "v"(a1)); asm("v_sad_u8 %0, %1, %2, %3" : "=v"(a2) : "v"(tb[i]), "v"(c4), "v"(a2)); } }
                    const int cnt = (ntot_b + grp16_sum((int)a1 - (int)a2)) >> 1;
                    if (cnt >= 256) Th = ch;
                }
                const unsigned th2 = (Th << 8) * 0x10001u;
#pragma unroll
                for (int g = 0; g < 4; ++g) if (g < ngrp) {
#pragma unroll
                  for (int i = 8 * g; i < 8 * g + 8; ++i) { unsigned zx, zy;
                    asm("v_pk_sub_u16 %0, %1, %2 clamp" : "=v"(zx) : "v"(v[i].x), "v"(th2)); asm("v_pk_min_u16 %0, %1, %2" : "=v"(zx) : "v"(zx), "v"(0x00ff00ffu));
                    asm("v_pk_sub_u16 %0, %1, %2 clamp" : "=v"(zy) : "v"(v[i].y), "v"(th2)); asm("v_pk_min_u16 %0, %1, %2" : "=v"(zy) : "v"(zy), "v"(0x00ff00ffu));
                    tb[i] = __builtin_amdgcn_perm(zy, zx, 0x06040200u); } }
                unsigned Tl = 0u;
                for (int bit = 7; bit >= 0; --bit) {
                    const unsigned cl = Tl | (1u << bit); const unsigned c4 = cl * 0x01010101u, m4 = (cl - 1u) * 0x01010101u; unsigned a1 = 0u, a2 = 0u;
#pragma unroll
                    for (int g = 0; g < 4; ++g) if (g < ngrp) {
#pragma unroll
                        for (int i = 8 * g; i < 8 * g + 8; ++i) { asm("v_sad_u8 %0, %1, %2, %3" : "=v"(a1) : "v"(tb[i]), "v"(m4), "v"(a1)); asm("v_sad_u8 %0, %1, %2, %3" : "=v"(a2) : "v"(tb[i]), "v"(c4), "v"(a2)); } }
                    const int cnt = (ntot_b + grp16_sum((int)a1 - (int)a2)) >> 1;
                    if (cnt >= 256) Tl = cl;
                }
                T = (Th << 8) | Tl;
            }
            int cgt, ceq;
            { unsigned sg = 0u, se = 0u; const unsigned tp = T * 0x10001u, tm1 = (T - 1u) * 0x10001u;
#pragma unroll
              for (int g = 0; g < 4; ++g) if (g < ngrp) {
#pragma unroll
                for (int i = 8 * g; i < 8 * g + 8; ++i) { sg = pk_wrapsum(sg, v[i].x, tp); sg = pk_wrapsum(sg, v[i].y, tp); se = pk_wrapsum(se, v[i].x, tm1); se = pk_wrapsum(se, v[i].y, tm1); } }
              const int npad = 32 * ngrp;
              cgt = ((int)sg - npad * (int)T + xthr) >> 16; ceq = (((int)se - npad * ((int)T - 1) + xthr) >> 16) - cgt; }
            const int need = 256 - grp16_sum(cgt);
            int rem = need - (grp16_incl_scan(ceq) - ceq);
            LAS unsigned* mrow = mask + q * MASK_PITCH_W;
            const unsigned tp2 = T * 0x10001u, tm2 = (T - 1u) * 0x10001u;
#pragma unroll
            for (int g = 0; g < 4; ++g) if (g < ngrp)
#pragma unroll
            for (int i = 8 * g; i < 8 * g + 8; ++i) {
                const unsigned gt = nib_gt(v[i].x, v[i].y, tp2), eqn = nib_gt(v[i].x, v[i].y, tm2) ^ gt;
                unsigned nib = gt;
                if (__any(eqn != 0u)) {
                    unsigned t = eqn;
#pragma unroll
                    for (int e = 0; e < 4; ++e) { const unsigned low = t & (0u - t); nib |= (rem > 0) ? low : 0u; rem -= (low != 0u) ? 1 : 0; t ^= low; }
                }
                const int pos = sub * nt + i;
                if (nib) atomicOr((unsigned*)(mrow + (pos >> 3)), nib << ((pos & 7) * 4));
            }
        }
        __syncthreads();
    }
#undef DSA_FIRST_LOADS
    f32x16 o[2];
#pragma unroll
    for (int e = 0; e < 2; ++e)
#pragma unroll
        for (int r = 0; r < 16; ++r) o[e][r] = 0.f;
    float m_run = -1e30f, l_run = 0.f;
    constexpr int KP = 144, VP = 192, KB = 64 * KP, BUFB = 64 * KP + 64 * VP;
    const float c2 = exp2f(-(float)(wave + 1)) * LOG2E;
    TileSc sf; sf.c1 = 0.125f * LOG2E; sf.c2 = c2; sf.fh = (float)(4 * hi); sf.tt = 2.f * c2 * (float)((t0 & 63) + r32); sf.m0 = 0xffffffffu; sf.m1 = 0xffffffffu; sf.diag = false;
    f32x16 kb0, kb1; make_kb(kb0, kb1, sf.c1, c2, hi);
    const bf16_t* src = proj + rowbase * PW;
    tile_store<128>(kr, lds, KP, tid); tile_store<128>(vr, lds + KB, VP, tid);
#pragma unroll
    for (int ks = 0; ks < 4; ++ks) asm volatile("" : "+v"(qf[ks]));
    const float qbnd = score_bound(qf, kmsq + b * 20 + 16, sf.c1, c2);
    bool live = true;
    __syncthreads();
    for (int it = 0; it < nt; ++it) {
        const int j = nt - 1 - it;
        LAS unsigned char* kb = lds + (it & 1) * BUFB; LAS unsigned char* nb = lds + ((it + 1) & 1) * BUFB;
        if (j > 0) { const bf16_t* sn = src + (size_t)(64 * (j - 1)) * PW; tile_load<128>(kr, sn + C_KB, PW, tid); tile_load<128>(vr, sn + C_VB, PW, tid); }
        if (live && it > 0 && !__any(qbnd > m_run)) live = false;
        if (live) {
        if (need_sel) { const u32x2 mw = *(const LAS u32x2*)(mask + r32 * MASK_PITCH_W + 2 * j); sf.m0 = mw.x >> (4 * hi); sf.m1 = mw.y >> (4 * hi); }
        sf.diag = (it == 0);
        attn_tile<64, 64, true, true, true>(kb, KP, kb + KB, VP, QReg<4>{qf}, o, m_run, l_run, sf, kb0, kb1, lane); m_run += 64.f * c2;
        }
        if (j > 0) { tile_store<128>(kr, nb, KP, tid); tile_store<128>(vr, nb + KB, VP, tid); }
#if REP_PHASE == 301
        __syncthreads();
        if (j > 0) { const bf16_t* sn = src + (size_t)(64 * (j - 1)) * PW; asm volatile("" : "+v"(kr.v[0]), "+v"(vr.v[0])); tile_load<128>(kr, sn + C_KB, PW, tid); tile_load<128>(vr, sn + C_VB, PW, tid);
            tile_store<128>(kr, nb, KP, tid); tile_store<128>(vr, nb + KB, VP, tid); }
#endif
#if REP_PHASE == 302
        { f32x16 o2[2]; float m2 = m_run, l2 = l_run; o2[0] = o[0]; o2[1] = o[1];
          attn_tile<64, 64, true, true, true>(kb, KP, kb + KB, VP, QReg<4>{qf}, o2, m2, l2, sf, kb0, kb1, lane);
          asm volatile("" :: "v"(o2[0]), "v"(o2[1]), "v"(m2), "v"(l2)); }
#endif
        __syncthreads();
    }
    const float ltot = xor32_sum(l_run);
    store_ot8_rows<2>(o, 8.f / ltot, lds + wave * 2560, yb + (rowbase + t0) * 1024 + wave * 64, 1024, lane);
    __syncthreads();
}

__device__ __forceinline__ void cross_unit(const bf16_t* qc, const bf16_t* kvc, unsigned char* oc, const int b, const int hx, const int qb, LAS unsigned char* lds, const int tid_in) {
    int tid = tid_in; asm volatile("" : "+v"(tid));
    const int wave = __builtin_amdgcn_readfirstlane(tid >> 6), lane = tid & 63, r32 = lane & 31, hi = lane >> 5;
    const int sb = wave & 3, eh = wave >> 2;
    const int t0 = qb * 128 + sb * 32;
    const size_t rowbase = (size_t)b * SEQ;
    constexpr int QP = 528, KP = 528, VP = 576, QB_ = 128 * QP, KB = 64 * KP;
    LAS unsigned char* Qs = lds; LAS unsigned char* Kt = lds + QB_; LAS unsigned char* Vt = Kt + KB;
    const bf16_t* src = kvc + (size_t)b * NMEM * 2048 + hx * 256;
    TileRegs<512> kr, vr;
    { const bf16_t* s0 = src + (size_t)(64 * (qb & 3)) * 2048; tile_load<512>(kr, s0, 2048, tid); tile_load<512>(vr, s0 + 1024, 2048, tid); }
    { const bf16_t* qsrc = qc + (rowbase + qb * 128) * 1024 + hx * 256;
#pragma unroll
      for (int c = 0; c < 8; ++c) { const int idx = tid + c * 512, row = idx >> 5, ch = idx & 31;
          const u32x4 v = *(const u32x4*)(qsrc + (size_t)row * 1024 + ch * 8); *(LAS u32x4*)(Qs + row * QP + ch * 16) = v; } }
    tile_store<512>(kr, Kt, KP, tid); tile_store<512>(vr, Vt, VP, tid);
    __syncthreads();
    f32x16 o[4];
#pragma unroll
    for (int e = 0; e < 4; ++e)
#pragma unroll
        for (int r = 0; r < 16; ++r) o[e][r] = 0.f;
    float m_run = -1e30f, l_run = 0.f;
    TileSc sf; sf.c1 = 0.0625f * LOG2E; sf.c2 = 0.f; sf.tt = 0.f; sf.fh = 0.f; sf.m0 = 0u; sf.m1 = 0u; sf.diag = false;
    f32x16 kbz;
#pragma unroll
    for (int r = 0; r < 16; ++r) kbz[r] = 0.f;
    const QLds ql{Qs + (sb * 32 + r32) * QP + hi * 16};
    for (int j = 0; j < 4; ++j) {
        if (j + 1 < 4) { const bf16_t* sn = src + (size_t)(64 * ((qb + j + 1) & 3)) * 2048; tile_load<512>(kr, sn, 2048, tid); tile_load<512>(vr, sn + 1024, 2048, tid); }
        attn_tile<256, 128, true, false, false>(Kt, KP, Vt + eh * 256, VP, ql, o, m_run, l_run, sf, kbz, kbz, lane);
        __syncthreads();
        if (j + 1 < 4) { tile_store<512>(kr, Kt, KP, tid); tile_store<512>(vr, Vt, VP, tid); __syncthreads(); }
    }
    const float ltot = xor32_sum(l_run);
    store_ot8_rows<4>(o, 16.f / ltot, lds + wave * 4608, oc + (rowbase + t0) * 1024 + hx * 256 + eh * 128, 1024, lane);
    __syncthreads();
}

__device__ __forceinline__ void moe_tables(const int* hist, LAS int* tab, const int tb_limit, const int tid) {
    const int e = tid & 31, part = tid >> 5;
    int tot = 0, pre = 0;
    for (int tb = part; tb < 256; tb += 16) { const int hv = hist[tb * 32 + e]; tot += hv; pre += (tb < tb_limit) ? hv : 0; }
    tab[128 + part * 32 + e] = tot; tab[1024 + part * 32 + e] = pre;
    __syncthreads();
    if (tid < 32) { int a = 0, p = 0;
#pragma unroll
        for (int k = 0; k < 16; ++k) { a += tab[128 + k * 32 + tid]; p += tab[1024 + k * 32 + tid]; }
        tab[tid] = a; tab[640 + tid] = p; }
    __syncthreads();
    if (tid == 0) { int ps = 0, rb = 0;
        for (int k = 0; k < 32; ++k) { tab[32 + k] = ps; tab[72 + k] = rb; const int nb = (tab[k] + 255) >> 8; ps += nb * 256; rb += nb; }
        tab[64] = ps; tab[104] = rb; tab[108] = rb; }
    __syncthreads();
    { const int n_rb = tab[108]; LAS unsigned char* rb2e = (LAS unsigned char*)(tab + 1600);
      for (int rb = tid; rb < n_rb; rb += 512) { int ee = 0;
#pragma unroll 4
          for (int k = 1; k < 32; ++k) ee += (rb >= tab[72 + k]) ? 1 : 0;
          rb2e[rb] = (unsigned char)ee; } }
    __syncthreads();
}

__device__ __forceinline__ void router_block(const bf16_t* h2, const bf16_t* wrh, LAS unsigned char* lds, const float* b_router, const float* b_group, const int tb,
                                             int* tok_e, float* tok_g, float* tok_inv, int* hist, LAS int* lhist, const int tid) {
    const int wave = __builtin_amdgcn_readfirstlane(tid >> 6), lane = tid & 63, r32 = lane & 31, hi = lane >> 5;
    if (tid < 32) lhist[tid] = 0;
    constexpr int RPB = 144, XTB = 32 * RPB, WTB = 64 * RPB;
    LAS unsigned char* XH = lds + wave * (2 * XTB); LAS unsigned char* XL = XH + XTB;
    LAS unsigned char* WT = lds + 8 * (2 * XTB);
    LAS float* SSX = (LAS float*)(WT + 4 * WTB) + wave * 32;
    for (int i = tid; i < 4 * WTB / 16; i += 512) *(LAS u32x4*)(WT + 16 * i) = (u32x4){0u, 0u, 0u, 0u};
    __syncthreads();
    const int tok0 = tb * 256 + wave * 32, tok = tok0 + r32;
    const bf16_t* xg = h2 + (size_t)(tok0 + (lane >> 4)) * 1024 + 4 * (lane & 15);
    const int wp0 = tid, wp1 = 512 + tid;
    u32x2 xr[2][8]; u32x4 wq0[2], wq1[2]; float sq[8];
#pragma unroll
    for (int i = 0; i < 8; ++i) sq[i] = 0.f;
#define RT_WSRC(p_, c_) (wrh + (size_t)((p_) / 288) * (36 * 1024) + (size_t)(((p_) % 288) >> 3) * 1024 + 64 * (c_) + 8 * ((p_) & 7))
#define RT_WDST(p_, b_) (WT + (b_) * (2 * WTB) + ((p_) / 288) * WTB + (((p_) % 288) >> 3) * RPB + 16 * ((p_) & 7))
#define RT_LOAD(k_, c_) do { _Pragma("unroll") for (int i_ = 0; i_ < 8; ++i_) xr[k_][i_] = *(const u32x2*)(xg + (size_t)(4 * i_) * 1024 + 64 * (c_)); \
        wq0[k_] = *(const u32x4*)RT_WSRC(wp0, c_); if (wp1 < 576) wq1[k_] = *(const u32x4*)RT_WSRC(wp1, c_); } while (0)
#define RT_STORE(k_, b_) do { _Pragma("unroll") for (int i_ = 0; i_ < 8; ++i_) { const u32x2 h_ = xr[k_][i_]; const f32x4 v_ = (f32x4){bf_lo(h_.x), bf_hi(h_.x), bf_lo(h_.y), bf_hi(h_.y)}; \
            sq[i_] += (v_.x * v_.x + v_.y * v_.y) + (v_.z * v_.z + v_.w * v_.w); \
            const int off_ = (4 * i_ + (lane >> 4)) * RPB + 8 * (lane & 15); *(LAS u32x2*)(XH + off_) = h_; } \
        *(LAS u32x4*)RT_WDST(wp0, b_) = wq0[k_]; if (wp1 < 576) *(LAS u32x4*)RT_WDST(wp1, b_) = wq1[k_]; } while (0)
    f32x16 acc, acc2;
#pragma unroll
    for (int r = 0; r < 16; ++r) { acc[r] = 0.f; acc2[r] = 0.f; }
#pragma unroll 1
    for (int c4 = 0; c4 < 16; c4 += 2) {
#pragma unroll
      for (int k = 0; k < 2; ++k) RT_LOAD(k, c4 + k);
#pragma unroll
      for (int k = 0; k < 2; ++k) { const int c = c4 + k;
        RT_STORE(k, k & 1);
        __syncthreads();
        const LAS unsigned char* xh = XH + r32 * RPB + 16 * hi;
        const LAS unsigned char* wh = WT + (c & 1) * (2 * WTB) + r32 * RPB + 16 * hi; const LAS unsigned char* wl = wh + WTB;
#pragma unroll
        for (int ks = 0; ks < 4; ++ks) {
            const bf16x8 bxh = *(const LAS bf16x8*)(xh + 32 * ks);
            const bf16x8 a1h = *(const LAS bf16x8*)(wh + 32 * ks), a1l = *(const LAS bf16x8*)(wl + 32 * ks);
            const bf16x8 a2h = *(const LAS bf16x8*)(wh + 32 * RPB + 32 * ks), a2l = *(const LAS bf16x8*)(wl + 32 * RPB + 32 * ks);
            acc = __builtin_amdgcn_mfma_f32_32x32x16_bf16(a1l, bxh, acc, 0, 0, 0); acc = __builtin_amdgcn_mfma_f32_32x32x16_bf16(a1h, bxh, acc, 0, 0, 0);
            acc2 = __builtin_amdgcn_mfma_f32_32x32x16_bf16(a2l, bxh, acc2, 0, 0, 0); acc2 = __builtin_amdgcn_mfma_f32_32x32x16_bf16(a2h, bxh, acc2, 0, 0, 0);
        }
      }
    }
#undef RT_LOAD
#undef RT_STORE
#undef RT_WSRC
#undef RT_WDST
#pragma unroll
    for (int i = 0; i < 8; ++i) { float v = sq[i];
        v += __builtin_bit_cast(float, __builtin_amdgcn_update_dpp(0, __builtin_bit_cast(int, v), 0x128, 0xf, 0xf, false));
        v += __builtin_bit_cast(float, __builtin_amdgcn_update_dpp(0, __builtin_bit_cast(int, v), 0x124, 0xf, 0xf, false));
        v += __builtin_bit_cast(float, __builtin_amdgcn_update_dpp(0, __builtin_bit_cast(int, v), 0x122, 0xf, 0xf, false));
        v += __builtin_bit_cast(float, __builtin_amdgcn_update_dpp(0, __builtin_bit_cast(int, v), 0x121, 0xf, 0xf, false));
        if ((lane & 15) == 0) SSX[4 * i + (lane >> 4)] = v; }
    __syncthreads();
    const float ss = SSX[r32];
    float gl[4];
#pragma unroll
    for (int g = 0; g < 4; ++g) gl[g] = hi ? 0.f : acc2[g];
    const float inv = rsqrtf(ss * (1.f / 1024.f) + EPS);
    float gmax = -INFINITY; int gi = 0;
#pragma unroll
    for (int g = 0; g < 4; ++g) { gl[g] = (gl[g] + __shfl_xor(gl[g], 32)) * inv + b_group[g]; if (gl[g] > gmax) { gmax = gl[g]; gi = g; } }
    float gz = 0.f;
#pragma unroll
    for (int g = 0; g < 4; ++g) gz += __expf(gl[g] - gmax);
    const float pg = 1.f / gz;
    float lv[4];
#pragma unroll
    for (int i = 0; i < 4; ++i) { float t = acc[i]; t = (gi == 1) ? acc[4 + i] : t; t = (gi == 2) ? acc[8 + i] : t; t = (gi == 3) ? acc[12 + i] : t;
        lv[i] = t * inv + b_router[8 * gi + 4 * hi + i]; }
    float e8[8];
#pragma unroll
    for (int i = 0; i < 4; ++i) { const float other = __shfl_xor(lv[i], 32); e8[i] = hi ? other : lv[i]; e8[4 + i] = hi ? lv[i] : other; }
    int i0 = 0; float l0 = e8[0];
#pragma unroll
    for (int i = 1; i < 8; ++i) if (e8[i] > l0) { l0 = e8[i]; i0 = i; }
    int i1 = -1; float l1 = -INFINITY;
#pragma unroll
    for (int i = 0; i < 8; ++i) if (i != i0 && e8[i] > l1) { l1 = e8[i]; i1 = i; }
    const float ex1 = __expf(l1 - l0), den = 1.f / (1.f + ex1);
    const int E0 = 8 * gi + i0, E1 = 8 * gi + i1;
    if (hi == 0) { tok_e[tok] = E0 | (E1 << 8); tok_g[2 * tok] = pg * den; tok_g[2 * tok + 1] = pg * ex1 * den; tok_inv[tok] = inv;
        atomicAdd((int*)(lhist + E0), 1); atomicAdd((int*)(lhist + E1), 1); }
    __syncthreads();
    if (tid < 32) hist[tb * 32 + tid] = lhist[tid];
    __syncthreads();
}

__device__ __forceinline__ int opaque_tid() { int t = threadIdx.x; asm volatile("" : "+v"(t)); return t; }
#define PHASE_IDS() const int tid = opaque_tid(); const int lane = tid & 63; const int wave = __builtin_amdgcn_readfirstlane(tid >> 6); (void)lane; (void)wave; DECL_PTRS()
enum { PH_PRO = 0, PH_PROJ, PH_MIX, PH_BRANCH, PH_OUT, PH_CQ, PH_CROSS, PH_CO, PH_ROUTE, PH_SLOT, PH_UP, PH_DOWN, PH_FINAL, N_PHASES };

struct Args { const float* in[28]; float* out; unsigned char* ws; int ph_lo, ph_hi; };

__global__ void __launch_bounds__(512, 2) fwd_kernel(Args args) {
    extern __shared__ __attribute__((aligned(16))) unsigned char lds_raw[];
    LAS unsigned char* lds = (LAS unsigned char*)lds_raw;
    const int tid = threadIdx.x, lane = tid & 63, wave = __builtin_amdgcn_readfirstlane(tid >> 6);
    const int G = gridDim.x, bx = blockIdx.x;
    unsigned char* ws = args.ws;
    volatile LAS unsigned* MISC = (volatile LAS unsigned*)(lds + MISC_OFF);
    LAS int* tab = (LAS int*)(lds + TAB_OFF);
    if (tid < 64) MISC[tid] = 0u;
    __syncthreads();
    const int lo = args.ph_lo, hi_ph = args.ph_hi;
    XcdBarrier bar; bar.bar = (unsigned*)(ws + WS_CTL) + CW_BAR; bar.x = 0; bar.st = MISC + 8;
    if (hi_ph - lo > 1) bar = xcd_barrier_post((unsigned*)(ws + WS_CTL) + CW_BAR, MISC + 8);
#define IN(k) (lo <= (k) && (k) < hi_ph)
#define SEAM(k) do { if (IN(k) && IN((k) + 1)) xcd_barrier(bar); } while (0)

#define KA_(T, off) (*(T const __attribute__((address_space(4)))*)(kp_ + (off)))
#define DECL_PTRS() const __attribute__((address_space(4))) char* kp_ = (const __attribute__((address_space(4))) char*)__builtin_amdgcn_kernarg_segment_ptr(); asm volatile("" : "+s"(kp_)); \
    const float* x = KA_(const float*, 8 * 0); const float* mem = KA_(const float*, 8 * 1); const float* mix_norm = KA_(const float*, 8 * 2); const float* w_in = KA_(const float*, 8 * 3); const float* lam_q1 = KA_(const float*, 8 * 4); const float* lam_k1 = KA_(const float*, 8 * 5); const float* lam_q2 = KA_(const float*, 8 * 6); const float* lam_k2 = KA_(const float*, 8 * 7); const float* diff_subln = KA_(const float*, 8 * 8); const float* w_branch_a = KA_(const float*, 8 * 9); const float* w_branch_b = KA_(const float*, 8 * 10); const float* w_gate = KA_(const float*, 8 * 11); const float* b_gate = KA_(const float*, 8 * 12); const float* w_out = KA_(const float*, 8 * 13); const float* cross_norm = KA_(const float*, 8 * 14); const float* mem_norm = KA_(const float*, 8 * 15); const float* w_cq = KA_(const float*, 8 * 16); const float* w_ckv = KA_(const float*, 8 * 17); const float* w_co = KA_(const float*, 8 * 18); const float* ffn_norm = KA_(const float*, 8 * 19); const float* w_group = KA_(const float*, 8 * 20); const float* b_group = KA_(const float*, 8 * 21); const float* w_router = KA_(const float*, 8 * 22); const float* b_router = KA_(const float*, 8 * 23); const float* w1 = KA_(const float*, 8 * 24); const float* w3 = KA_(const float*, 8 * 25); const float* w2 = KA_(const float*, 8 * 26); const float* final_norm = KA_(const float*, 8 * 27); float* out = KA_(float*, 224); unsigned char* ws = KA_(unsigned char*, 232); float* rowss = (float*)(ws + WS_ROWSS); int* tok_e = (int*)(ws + WS_TOKE); float* tok_g = (float*)(ws + WS_TOKG); int* hist = (int*)(ws + WS_HIST); bf16_t* wrh = (bf16_t*)(ws + WS_WRT); int* sdest = (int*)(ws + WS_SDEST); float* sgate = (float*)(ws + WS_SGATE); int* stok = (int*)(ws + WS_STOK); float* tok_inv = (float*)(ws + WS_TOKINV); float* siv = (float*)(ws + WS_SIV); unsigned char* W8 = ws + WS_WCAT; bf16_t* Wi = (bf16_t*)(ws + WS_WCAT + 5 * MiB); unsigned char* Wa = ws + WS_WA; unsigned char* Wb = ws + WS_WB; unsigned char* Wout = ws + WS_WOUT; unsigned char* Wcq = ws + WS_WCQ; unsigned char* Wckv = ws + WS_WCKV;  unsigned char* Wco = ws + WS_WCO; unsigned char* W13 = ws + WS_W13; unsigned char* W2 = ws + WS_W2; unsigned char* memn8 = ws + WS_MEMN; bf16_t* kvc = (bf16_t*)(ws + WS_KVC); bf16_t* xn = (bf16_t*)(ws + WS_R1); bf16_t* merged = xn; unsigned char* xn2_8 = ws + WS_R1; unsigned char* merged8 = ws + WS_R3 + 128 * MiB; unsigned char* xn8 = ws + WS_R4; unsigned char* hb3 = ws + WS_R1; bf16_t* proj = (bf16_t*)(ws + WS_R2); bf16_t* qc = proj; unsigned char* oc = ws + WS_R2 + (size_t)NTOK * 1024 * 2; bf16_t* xs = proj; unsigned char* gates = ws + WS_R3; unsigned char* y2 = ws + WS_R3; unsigned char* ya = ws + WS_R4; unsigned char* yb = ya + 512; unsigned char* hmid = ws + WS_R4; bf16_t* h1b = (bf16_t*)out; bf16_t* h2b = (bf16_t*)(ws + WS_R2 + 192 * MiB); \
    (void)x; (void)mem; (void)mix_norm; (void)w_in; (void)lam_q1; (void)lam_k1; (void)lam_q2; (void)lam_k2; (void)diff_subln; (void)w_branch_a; (void)w_branch_b; (void)w_gate; (void)b_gate; (void)w_out; \
    (void)cross_norm; (void)mem_norm; (void)w_cq; (void)w_ckv; (void)w_co; (void)ffn_norm; (void)w_group; (void)b_group; (void)w_router; (void)b_router; (void)w1; (void)w3; (void)w2; (void)final_norm; (void)out; \
    (void)rowss; (void)tok_e; (void)tok_g; (void)hist; (void)wrh; (void)sdest; (void)sgate; (void)W8; (void)Wi; (void)Wa; (void)Wb; (void)Wout; (void)Wcq; (void)Wckv; (void)Wco; (void)W13; (void)W2; (void)memn8; (void)merged8; (void)xn8; (void)xn2_8; (void)kvc; \
    (void)stok; (void)tok_inv; (void)siv; (void)hb3; (void)xn; (void)merged; (void)proj; (void)qc; (void)oc; (void)xs; (void)gates; (void)y2; (void)ya; (void)yb; (void)hmid; (void)h1b; (void)h2b; (void)ws

    if (IN(PH_PRO)) for (int rep_ = 0; rep_ < REPS(PH_PRO); ++rep_) { PHASE_IDS();
        LAS float* scr = (LAS float*)(lds + wave * 8704);
        const int gw = bx * 8 + wave, NGW = G * 8;
        constexpr int I0 = 16 * 72, I0C = 16 * 16, I1 = 16 * 64, I2 = 8 * 32, I4 = 16 * 32, I6 = 16 * 64, IE = 256;
        constexpr int NITEMS = I0 + I0C + I1 + 2 * I2 + 3 * I4 + I6 + 3 * 32 * IE;
        for (int it = gw; it < NITEMS; it += NGW) {
            int r = it;
            if (r < I0) { const int kb = r / 72, nb = r % 72; tr_item8(w_in, 2500, 2176, 32 * nb, 64 * kb, W8 + (size_t)(32 * nb) * 1024, 1024, 32.f, scr, lane); continue; } r -= I0;
            if (r < I0C) { const int kb = r / 16, nb = r % 16; tr_item(w_in, 2500, 2500, C_QI + 32 * nb, 64 * kb, Wi + (size_t)(32 * nb) * 1024, 1024, scr, lane); continue; } r -= I0C;
            if (r < I1) { const int kb = r / 64, nb = r % 64; tr_item8<true>(w_gate, 2048, 2048, 32 * nb, 64 * kb, W8 + (size_t)2304 * 1024, 1024, 32.f, scr, lane); continue; } r -= I1;
            if (r < I2) { const int kb = r / 32, nb = r % 32; tr_item8(w_branch_a, 1024, 1024, 32 * nb, 64 * kb, Wa + (size_t)(32 * nb) * 1024, 1024, 16.f, scr, lane); continue; } r -= I2;
            if (r < I2) { const int kb = r / 32, nb = r % 32; tr_item8(w_branch_b, 1024, 1024, 32 * nb, 64 * kb, Wa + 512 + (size_t)(32 * nb) * 1024, 1024, 16.f, scr, lane); continue; } r -= I2;
            if (r < I4) { const int kb = r / 32, nb = r % 32; tr_item8(w_out, 1024, 1024, 32 * nb, 64 * kb, Wout + (size_t)(32 * nb) * 1024, 1024, 32.f, scr, lane); continue; } r -= I4;
            if (r < I4) { const int kb = r / 32, nb = r % 32; tr_item8(w_cq, 1024, 1024, 32 * nb, 64 * kb, Wcq + (size_t)(32 * nb) * 1024, 1024, 32.f, scr, lane); continue; } r -= I4;
            if (r < I6) { const int kb = r / 64, nb = r % 64; tr_item8(w_ckv, 2048, 2048, 32 * nb, 64 * kb, Wckv + (size_t)(32 * nb) * 1024, 1024, 32.f, scr, lane); continue; } r -= I6;
            if (r < I4) { const int kb = r / 32, nb = r % 32; tr_item8(w_co, 1024, 1024, 32 * nb, 64 * kb, Wco + (size_t)(32 * nb) * 1024, 1024, 32.f, scr, lane); continue; } r -= I4;
            if (r < 32 * IE) { const int e = r / IE, q = r % IE, kb = q / 16, nb = q % 16, n0 = 32 * nb;
                tr_item8(w1 + (size_t)e * 1024 * 512, 512, 512, n0, 64 * kb, W13 + ((size_t)e * 1024 + 256 * (n0 >> 7) + (n0 & 127)) * 1024, 1024, 32.f, scr, lane); continue; } r -= 32 * IE;
            if (r < 32 * IE) { const int e = r / IE, q = r % IE, kb = q / 16, nb = q % 16, n0 = 32 * nb;
                tr_item8(w3 + (size_t)e * 1024 * 512, 512, 512, n0, 64 * kb, W13 + ((size_t)e * 1024 + 256 * (n0 >> 7) + 128 + (n0 & 127)) * 1024, 1024, 32.f, scr, lane); continue; } r -= 32 * IE;
            { const int e = r / IE, q = r % IE, kb = q / 32, nb = q % 32;
                tr_item8(w2 + (size_t)e * 512 * 1024, 1024, 1024, 32 * nb, 64 * kb, W2 + ((size_t)e * 1024 + 32 * nb) * 512, 512, 32.f, scr, lane); }
        }
        for (int m = 4 * gw; m < NTOK; m += 4 * NGW) rms_rows4_fp8<true>(x + (size_t)m * 1024, 1024, mix_norm, xn8 + (size_t)m * 1024, xn + (size_t)m * 1024, lane);
        for (int m = 4 * gw; m < NB * NMEM; m += 4 * NGW) rms_rows4_fp8<false>(mem + (size_t)m * 1024, 1024, mem_norm, memn8 + (size_t)m * 1024, (bf16_t*)nullptr, lane);
        for (int i = bx * 512 + tid; i < NTOK; i += G * 512) rowss[i] = 0.f;
        for (int i = bx * 512 + tid; i < 36 * 1024; i += G * 512) { const int j = i >> 10, k = i & 1023;
            const float w = ffn_norm[k] * (j < 32 ? w_router[k * 32 + j] : w_group[k * 4 + (j - 32)]);
            const unsigned hb = cvt_pk_bf16(w, 0.f) & 0xffffu; const float wl = w - bf_lo(hb);
            wrh[i] = (bf16_t)hb; wrh[36 * 1024 + i] = (bf16_t)(cvt_pk_bf16(wl, 0.f) & 0xffffu); }
    }
    SEAM(PH_PRO);

    if (IN(PH_PROJ)) for (int rep_ = 0; rep_ < REPS(PH_PROJ); ++rep_) { PHASE_IDS();
        LAS float* bgl = (LAS float*)(lds + 131072);
        for (int i = tid; i < 2048; i += 512) bgl[i] = b_gate[i];
        unsigned* kmsq = (unsigned*)(ws + WS_CTL + WS_KMSQ);
        { pg8::Gemm g{(const bf16_t*)xn8, (const bf16_t*)W8, 1024}; pg8::StaticOrder S; S.init(NTOK, 4352, 512, G, bx);
          pg8::EpiProj E{proj, gates, bgl, 0, kmsq}; pg8::gemm_phase<false, true>(lds, g, S, E); }
        { pg8::Gemm g{xn, Wi, 1024}; pg8::StaticOrder S; S.init(NTOK, 512, 1024, G, bx);
          pg8::EpiProj E{proj, gates, bgl, 1, kmsq}; pg8::gemm_phase(lds, g, S, E); }
        { pg8::Gemm g{(const bf16_t*)memn8, (const bf16_t*)Wckv, 1024}; pg8::StaticOrder S; S.init(NB * NMEM, 2048, 512, G, bx); pg8::EpiPlain E{kvc, 2048, 1.f / 32.f}; pg8::gemm_phase<false, true>(lds, g, S, E); }
    }
    SEAM(PH_PROJ);

    if (IN(PH_MIX)) { PHASE_IDS();
        float lam;
        { const float a = wave_sum(lam_q1[lane] * lam_k1[lane]), c = wave_sum(lam_q2[lane] * lam_k2[lane]); lam = __expf(a) - __expf(c) + 0.2f; }
        const int vcu = (G % 8 == 0) ? (bx % 8) * (G / 8) + bx / 8 : bx;
        const unsigned* kmsq = (const unsigned*)(ws + WS_CTL + WS_KMSQ);
        if (tid < 128) ((LAS float*)(lds + 131072))[tid] = diff_subln[tid];
        for (int rep_ = 0; rep_ < REPS(100); ++rep_)
        for (int L = vcu; L < 2048; L += G) { const int i = L >> 8, c = L & 255, grp = c >> 4, k = c & 15, bh = grp * 8 + i;
            const int qb = (i & 1) ? (15 - k) : k;
            diffattn_unit(proj, ya, diff_subln, lam, kmsq, bh >> 2, bh & 3, qb, lds, tid); }
        for (int rep_ = 0; rep_ < REPS(101); ++rep_)
        for (int L = vcu; L < 2048; L += G) { const int i = L >> 8, c = L & 255, grp = c >> 4, k = c & 15, b = grp * 2 + (i >> 2), ii = i & 3;
            const int qblk = (ii == 0) ? k : (ii == 1) ? (31 - k) : (ii == 2) ? (32 + k) : (63 - k);
            dsa_unit(proj, yb, kmsq, b, qblk, lds, tid); }
    }
    SEAM(PH_MIX);

    const bool chain = (G == 256) && (lo == 0) && (hi_ph == N_PHASES);
    if (chain) { PHASE_IDS();
        const int panel = (bx % 8) * 32 + bx / 8;
        { pg8::Gemm g{(const bf16_t*)ya, (const bf16_t*)Wa, 1024}; pg8::PanelOrder S; S.init(panel, 1024, 512); pg8::EpiBranchF E{gates, merged8}; pg8::gemm_phase<false, true>(lds, g, S, E); }
        { pg8::Gemm g{(const bf16_t*)merged8, (const bf16_t*)Wout, 1024}; pg8::PanelOrder S; S.init(panel, 1024, 512); pg8::EpiResidSq E{x, h1b, xn2_8, cross_norm, rowss, 1.f / 256.f}; pg8::gemm_phase<false, true>(lds, g, S, E); }
        { pg8::Gemm g{(const bf16_t*)xn2_8, (const bf16_t*)Wcq, 1024}; pg8::PanelOrder S; S.init(panel, 1024, 512); pg8::EpiRowScale E{qc, 1024, rowss, 1.f / 32.f}; pg8::gemm_phase<false, true>(lds, g, S, E); }
        for (int u = 0; u < 8; ++u) cross_unit(qc, kvc, oc, panel >> 3, u >> 1, 2 * (panel & 7) + (u & 1), lds, tid);
        { pg8::Gemm g{(const bf16_t*)oc, (const bf16_t*)Wco, 1024}; pg8::PanelOrder S; S.init(panel, 1024, 512); pg8::EpiResidHb E{h1b, h2b, hb3, ffn_norm, 1.f / 512.f}; pg8::gemm_phase<false, true>(lds, g, S, E); }
        router_block(h2b, wrh, lds, b_router, b_group, panel, tok_e, tok_g, tok_inv, hist, tab, tid);
    }

    if (IN(PH_BRANCH) && !chain) for (int rep_ = 0; rep_ < REPS(PH_BRANCH); ++rep_) { PHASE_IDS();
        pg8::Gemm g{(const bf16_t*)ya, (const bf16_t*)Wa, 1024}; pg8::StaticOrder S; S.init(NTOK, 1024, 512, G, bx); pg8::EpiBranchF E{gates, merged8}; pg8::gemm_phase<false, true>(lds, g, S, E);
    }
    if (!chain) SEAM(PH_BRANCH);

    if (IN(PH_OUT) && !chain) for (int rep_ = 0; rep_ < REPS(PH_OUT); ++rep_) { PHASE_IDS();
        { pg8::Gemm g{(const bf16_t*)merged8, (const bf16_t*)Wout, 1024}; pg8::StaticOrder S; S.init(NTOK, 1024, 512, G, bx); pg8::EpiResidSq E{x, h1b, xn2_8, cross_norm, rowss, 1.f / 256.f}; pg8::gemm_phase<false, true>(lds, g, S, E); }
    }
    if (!chain) SEAM(PH_OUT);

    if (IN(PH_CQ) && !chain) for (int rep_ = 0; rep_ < REPS(PH_CQ); ++rep_) { PHASE_IDS();
        pg8::Gemm g{(const bf16_t*)xn2_8, (const bf16_t*)Wcq, 1024}; pg8::StaticOrder S; S.init(NTOK, 1024, 512, G, bx); pg8::EpiRowScale E{qc, 1024, rowss, 1.f / 32.f}; pg8::gemm_phase<false, true>(lds, g, S, E);
    }
    if (!chain) SEAM(PH_CQ);

    if (IN(PH_CROSS) && !chain) for (int rep_ = 0; rep_ < REPS(PH_CROSS); ++rep_) { PHASE_IDS();
        const int vcu = (G % 8 == 0) ? (bx % 8) * (G / 8) + bx / 8 : bx;
        for (int L = vcu; L < 2048; L += G) { const int i = L >> 8, c = L & 255, bhx = (c >> 4) * 8 + i; cross_unit(qc, kvc, oc, bhx >> 2, bhx & 3, c & 15, lds, tid); }
    }
    if (!chain) SEAM(PH_CROSS);

    if (IN(PH_CO) && !chain) { PHASE_IDS();
        pg8::Gemm g{(const bf16_t*)oc, (const bf16_t*)Wco, 1024}; pg8::StaticOrder S; S.init(NTOK, 1024, 512, G, bx); pg8::EpiResidHb E{h1b, h2b, hb3, ffn_norm, 1.f / 512.f}; pg8::gemm_phase<false, true>(lds, g, S, E);
    }
    if (!chain) SEAM(PH_CO);

    if (IN(PH_ROUTE) && !chain) for (int rep_ = 0; rep_ < REPS(PH_ROUTE); ++rep_) { PHASE_IDS();
        for (int tb = bx; tb < 256; tb += G) router_block(h2b, wrh, lds, b_router, b_group, tb, tok_e, tok_g, tok_inv, hist, tab, tid);
    }
    SEAM(PH_ROUTE);

    if (IN(PH_SLOT)) for (int rep_ = 0; rep_ < REPS(PH_SLOT); ++rep_) { PHASE_IDS();
        for (int tb = bx; tb < 256; tb += G) {
            moe_tables(hist, tab, tb, tid);
            LAS int* wcnt = tab + 700;
            int E0 = 0, E1 = 0, r0 = 0, r1 = 0;
            if (tid < 256) {
                const int pe = tok_e[tb * 256 + tid]; E0 = pe & 255; E1 = pe >> 8;
                const unsigned long long lt = (1ull << lane) - 1ull;
                for (int e = 0; e < 32; ++e) { const unsigned long long mk = __ballot((E0 == e) || (E1 == e));
                    const int rk = __popcll(mk & lt);
                    if (E0 == e) r0 = rk; if (E1 == e) r1 = rk;
                    if (lane == 0) wcnt[wave * 32 + e] = __popcll(mk); }
            }
            __syncthreads();
            if (tid < 256) {
                int o0 = 0, o1 = 0;
                for (int w = 0; w < wave; ++w) { o0 += wcnt[w * 32 + E0]; o1 += wcnt[w * 32 + E1]; }
                const int s0 = tab[32 + E0] + tab[640 + E0] + o0 + r0, s1 = tab[32 + E1] + tab[640 + E1] + o1 + r1;
                const int tok = tb * 256 + tid;
                sdest[s0] = 2 * tok; sdest[s1] = 2 * tok + 1; sgate[s0] = tok_g[2 * tok]; sgate[s1] = tok_g[2 * tok + 1]; stok[s0] = tok; stok[s1] = tok; { const float iv = tok_inv[tok] * (1.f / 32.f); siv[s0] = iv; siv[s1] = iv; }
            }
            if (tb == 0) {
                for (int e = wave; e < 32; e += 8) { const int cnt = tab[e], st = tab[32 + e], pend = ((cnt + 255) >> 8) << 8;
                    for (int s = cnt + lane; s < pend; s += 64) { sdest[st + s] = -1; sgate[st + s] = 0.f; stok[st + s] = 0; siv[st + s] = 0.f; } }
            }
            __syncthreads();
        }
    }
    SEAM(PH_SLOT);

    if (IN(PH_UP)) for (int rep_ = 0; rep_ < REPS(PH_UP); ++rep_) { PHASE_IDS();
        moe_tables(hist, tab, 0, tid);
        pg8::Gemm g{(const bf16_t*)hb3, (const bf16_t*)W13, 1024};
        pg8::MoeOrder S; S.G = G; S.c = bx; S.n_units = tab[108] * 4; S.rb2e = (const LAS unsigned char*)(tab + 1600); S.ridx = stok;
        S.a_step = 0; S.b_estep = (size_t)1024 * 1024; S.b_tstep = (size_t)256 * 1024;
        pg8::EpiSwiGLU E{hmid, sgate, siv};
        pg8::gemm_phase<true, true>(lds, g, S, E);
    }
    SEAM(PH_UP);

    if (IN(PH_DOWN)) for (int rep_ = 0; rep_ < REPS(PH_DOWN); ++rep_) { PHASE_IDS();
        moe_tables(hist, tab, 0, tid);
        pg8::Gemm g{(const bf16_t*)hmid, (const bf16_t*)W2, 512};
        pg8::MoeOrder S; S.G = G; S.c = bx; S.n_units = tab[108] * 4; S.rb2e = (const LAS unsigned char*)(tab + 1600);
        S.a_step = (size_t)256 * 512; S.b_estep = (size_t)1024 * 512; S.b_tstep = (size_t)256 * 512; S.ridx = nullptr;
        pg8::EpiDown E{y2, sdest};
        pg8::gemm_phase<false, true>(lds, g, S, E);
    }
    SEAM(PH_DOWN);

    if (IN(PH_FINAL)) { PHASE_IDS();
        const int gw = bx * 8 + wave, NGW = G * 8;
        for (int m = gw; m < NTOK; m += NGW) {
            f32x4* xr = (f32x4*)(out + (size_t)m * 1024) + lane; const f32x4* gr = (const f32x4*)final_norm + lane; const u32x2* hr = (const u32x2*)(h2b + (size_t)m * 1024) + lane;
            const unsigned* ya_ = (const unsigned*)(y2 + (size_t)(2 * m) * 1024) + lane; const unsigned* yb_ = (const unsigned*)(y2 + (size_t)(2 * m + 1) * 1024) + lane;
            f32x4 v[4]; float s = 0.f;
#pragma unroll
            for (int j = 0; j < 4; ++j) { const u32x2 hw = hr[64 * j]; v[j] = (f32x4){bf_lo(hw.x), bf_hi(hw.x), bf_lo(hw.y), bf_hi(hw.y)}; const int a = (int)ya_[64 * j], c = (int)yb_[64 * j];
                const f32x2 a0 = __builtin_amdgcn_cvt_pk_f32_fp8(a, false), a1 = __builtin_amdgcn_cvt_pk_f32_fp8(a, true), c0 = __builtin_amdgcn_cvt_pk_f32_fp8(c, false), c1 = __builtin_amdgcn_cvt_pk_f32_fp8(c, true);
                v[j].x += (a0.x + c0.x) * (1.f / 16.f); v[j].y += (a0.y + c0.y) * (1.f / 16.f); v[j].z += (a1.x + c1.x) * (1.f / 16.f); v[j].w += (a1.y + c1.y) * (1.f / 16.f);
                s += (v[j].x * v[j].x + v[j].y * v[j].y) + (v[j].z * v[j].z + v[j].w * v[j].w); }
            const float r = rsqrtf(wave_sum(s) * (1.f / 1024.f) + EPS);
#pragma unroll
            for (int j = 0; j < 4; ++j) { const f32x4 gv = gr[64 * j]; xr[64 * j] = (f32x4){v[j].x * r * gv.x, v[j].y * r * gv.y, v[j].z * r * gv.z, v[j].w * r * gv.w}; }
        }
    }
#undef IN
#undef SEAM
}

extern "C" void kernel_launch(void* const* d_in, const int* in_sizes, int n_in, void* d_out, int out_size, void* d_ws, size_t ws_size, hipStream_t stream) {
    static int grid = 0;
    if (grid == 0) {
        if (n_in != 28 || out_size != NTOK * DM || ws_size < WS_END) { fprintf(stderr, "kernel_launch: unexpected shapes (n_in %d out %d ws %zu)\n", n_in, out_size, ws_size); grid = -1; return; }
        int dev = 0, cus = 0, per_cu = 0;
        if (hipGetDevice(&dev) != hipSuccess || hipDeviceGetAttribute(&cus, hipDeviceAttributeMultiprocessorCount, dev) != hipSuccess) { grid = -1; return; }
        if (hipFuncSetAttribute((const void*)fwd_kernel, hipFuncAttributeMaxDynamicSharedMemorySize, LDS_BYTES) != hipSuccess) { fprintf(stderr, "kernel_launch: hipFuncSetAttribute failed\n"); grid = -1; return; }
        if (hipOccupancyMaxActiveBlocksPerMultiprocessor(&per_cu, (const void*)fwd_kernel, 512, LDS_BYTES) != hipSuccess || per_cu < 1) { fprintf(stderr, "kernel_launch: occupancy query says %d\n", per_cu); }
        (void)hipGetLastError();
        grid = cus;
    }
    if (grid < 0) return;
    hipMemsetAsync((char*)d_ws + WS_CTL, 0, CTL_ZERO_BYTES, stream);
    Args a{};
    for (int i = 0; i < 28; ++i) a.in[i] = (const float*)d_in[i];
    a.out = (float*)d_out; a.ws = (unsigned char*)d_ws;
#if N_LAUNCH_SPLIT
    for (int p = 0; p < N_PHASES; ++p) { a.ph_lo = p; a.ph_hi = p + 1; hipLaunchKernelGGL(fwd_kernel, dim3(grid), dim3(512), LDS_BYTES, stream, a); }
#else
    a.ph_lo = 0; a.ph_hi = N_PHASES; hipLaunchKernelGGL(fwd_kernel, dim3(grid), dim3(512), LDS_BYTES, stream, a);
#endif
}
```
